# Optimizing an MI355X kernel written in HIP

```python
import jax, jax.numpy as jnp
from jax import lax
import numpy as np

D_MODEL = 1024
BATCH = 2
SEQ = 16384
DEPTH = 4

HEAD_DIM = 64
N_ATTN_HEADS = 8
N_KV_GROUPS = 2
HEADS_PER_GROUP = N_ATTN_HEADS // N_KV_GROUPS
ATTN_WIDTH = N_ATTN_HEADS * HEAD_DIM
CONV_WIDTH = D_MODEL - ATTN_WIDTH
KV_WIDTH = N_KV_GROUPS * HEAD_DIM
N_BRANCH = 3
CMP_BLOCK = 32
CMP_STRIDE = 16
CMP_HIDDEN = 4 * HEAD_DIM
SEL_BLOCK = 64
SEL_TOPK = 16
WINDOW = 512
Q_BLOCK = 128
CONV_K = 3
D_FF = 4 * D_MODEL
IN_WIDTH = ATTN_WIDTH + 6 * KV_WIDTH + N_BRANCH * N_ATTN_HEADS + 3 * CONV_WIDTH
EPS = 1e-6
NEG = -1e30
FORCE_BONUS = 1e4

kernel_name = "nsa_shortconv_hymba_trunk"


def rms_norm(x, g):
    xf = x.astype(jnp.float32)
    y = xf * lax.rsqrt(jnp.mean(xf * xf, axis=-1, keepdims=True) + EPS)
    return (y * g.astype(jnp.float32)).astype(x.dtype)


def alibi_slopes():
    h = np.arange(1, N_ATTN_HEADS + 1, dtype=np.float32)
    s = np.power(np.float32(2.0), -8.0 * h / N_ATTN_HEADS).astype(np.float32)
    return jnp.asarray(s, dtype=jnp.float32).reshape(N_KV_GROUPS, HEADS_PER_GROUP)


def masked_softmax(s, mask):
    s = jnp.where(mask, s, NEG)
    m = jnp.max(s, axis=-1, keepdims=True)
    p = jnp.where(mask, jnp.exp(s - m), 0.0)
    return p / jnp.maximum(jnp.sum(p, axis=-1, keepdims=True), 1e-30)


def cmp_to_sel_matrix(n_cmp, n_sel):
    s0 = jnp.arange(n_cmp)[:, None] * CMP_STRIDE
    s1 = jnp.arange(n_sel)[None, :] * SEL_BLOCK
    shared = jnp.clip(jnp.minimum(s0 + CMP_BLOCK, s1 + SEL_BLOCK) - jnp.maximum(s0, s1), 0, None)
    return shared.astype(jnp.float32) / CMP_BLOCK


def compress(k_raw, pe, w1, b1, w2, b2):
    B, T = k_raw.shape[0], k_raw.shape[1]
    ch = k_raw.reshape(B, T // CMP_STRIDE, CMP_STRIDE, N_KV_GROUPS, HEAD_DIM)
    blk = jnp.concatenate([ch[:, :-1], ch[:, 1:]], axis=2)
    blk = blk + pe[None, None, :, None, :]
    blk = blk.transpose(0, 3, 1, 2, 4).reshape(B, N_KV_GROUPS, -1, CMP_BLOCK * HEAD_DIM)
    hdn = jax.nn.gelu(blk @ w1 + b1)
    return hdn @ w2 + b2


def nsa_attention(q, k_cmp, v_cmp, k_slc, v_slc, k_win, v_win, gates):
    B, T = q.shape[0], q.shape[1]
    G, R, hd = N_KV_GROUPS, HEADS_PER_GROUP, HEAD_DIM
    f32 = jnp.float32
    n_cmp = k_cmp.shape[2]
    n_sel = T // SEL_BLOCK
    n_top = min(SEL_TOPK, n_sel)
    n_qb = T // Q_BLOCK
    slopes = alibi_slopes()[None, :, :, None, None]
    sel_map = cmp_to_sel_matrix(n_cmp, n_sel)
    cmp_end = jnp.arange(n_cmp, dtype=jnp.int32) * CMP_STRIDE + (CMP_BLOCK - 1)
    sel_id = jnp.arange(n_sel, dtype=jnp.int32)
    sel_off = jnp.arange(SEL_BLOCK, dtype=jnp.int32)
    win_off = jnp.arange(Q_BLOCK + WINDOW, dtype=jnp.int32) - WINDOW
    ks_blk = k_slc.reshape(B, n_sel, SEL_BLOCK, G, hd).transpose(0, 3, 1, 2, 4)
    vs_blk = v_slc.reshape(B, n_sel, SEL_BLOCK, G, hd).transpose(0, 3, 1, 2, 4)
    kw_pad = jnp.pad(k_win, ((0, 0), (WINDOW, 0), (0, 0), (0, 0)))
    vw_pad = jnp.pad(v_win, ((0, 0), (WINDOW, 0), (0, 0), (0, 0)))
    q_blocks = (q * (hd ** -0.5)).reshape(B, n_qb, Q_BLOCK, G, R, hd).transpose(1, 0, 3, 4, 2, 5)
    g_blocks = gates.reshape(B, n_qb, Q_BLOCK, G, R, N_BRANCH).transpose(1, 0, 3, 4, 2, 5)
    b_ix = jnp.arange(B)[:, None, None, None]
    g_ix = jnp.arange(G)[None, :, None, None]

    def one_block(args):
        c, qb, gb = args
        q0 = c * Q_BLOCK
        t = q0 + jnp.arange(Q_BLOCK, dtype=jnp.int32)
        s = jnp.einsum('bgrqd,bgid->bgrqi', qb, k_cmp).astype(f32)
        dist = (t[:, None] - cmp_end[None, :]).astype(f32)
        p_cmp = masked_softmax(s - slopes * dist, dist >= 0)
        o_cmp = jnp.einsum('bgrqi,bgid->bgrqd', p_cmp.astype(v_cmp.dtype), v_cmp)
        imp = jnp.einsum('bgrqi,ij->bgqj', p_cmp, sel_map)
        jt = (t // SEL_BLOCK)[:, None]
        forced = (sel_id == 0) | (sel_id == jt) | (sel_id == jt - 1)
        valid = sel_id * SEL_BLOCK <= t[:, None]
        imp = jnp.where(valid, jnp.where(forced, imp + FORCE_BONUS, imp), NEG)
        _, idx = lax.top_k(imp, n_top)
        kg = ks_blk[b_ix, g_ix, idx].reshape(B, G, Q_BLOCK, n_top * SEL_BLOCK, hd)
        vg = vs_blk[b_ix, g_ix, idx].reshape(B, G, Q_BLOCK, n_top * SEL_BLOCK, hd)
        pos = (idx[..., None] * SEL_BLOCK + sel_off).reshape(B, G, Q_BLOCK, n_top * SEL_BLOCK)
        dist = (t[None, None, :, None] - pos).astype(f32)[:, :, None]
        s = jnp.einsum('bgrqd,bgqmd->bgrqm', qb, kg).astype(f32)
        p_slc = masked_softmax(s - slopes * dist, dist >= 0)
        o_slc = jnp.einsum('bgrqm,bgqmd->bgrqd', p_slc.astype(vg.dtype), vg)
        kw = lax.dynamic_slice_in_dim(kw_pad, q0, Q_BLOCK + WINDOW, axis=1)
        vw = lax.dynamic_slice_in_dim(vw_pad, q0, Q_BLOCK + WINDOW, axis=1)
        spos = q0 + win_off
        dist_i = t[:, None] - spos[None, :]
        mask = (spos[None, :] >= 0) & (dist_i >= 0) & (dist_i < WINDOW)
        s = jnp.einsum('bgrqd,bsgd->bgrqs', qb, kw).astype(f32)
        p_win = masked_softmax(s - slopes * dist_i.astype(f32), mask)
        o_win = jnp.einsum('bgrqs,bsgd->bgrqd', p_win.astype(vw.dtype), vw)
        o = gb[..., 0:1] * o_cmp + gb[..., 1:2] * o_slc + gb[..., 2:3] * o_win
        return o.astype(q.dtype)

    out = lax.map(one_block, (jnp.arange(n_qb, dtype=jnp.int32), q_blocks, g_blocks))
    return out.transpose(1, 0, 4, 2, 3, 5).reshape(B, T, N_ATTN_HEADS * hd)


def short_conv_mixer(h, c_gate, b_gate, conv_w):
    u = c_gate * h
    v = lax.conv_general_dilated(u, conv_w[:, None, :], window_strides=(1,),
                                 padding=((CONV_K - 1, 0),),
                                 dimension_numbers=('NWC', 'WIO', 'NWC'),
                                 feature_group_count=CONV_WIDTH)
    return b_gate * v


def setup_inputs(seed: int = 0) -> dict:
    key = jax.random.key(seed)
    ks = jax.random.split(key, 16)
    f32 = jnp.float32

    def nrm(k, shape, scale):
        return jax.random.normal(k, shape, f32) * scale

    return {
        'x': nrm(ks[0], (BATCH, SEQ, D_MODEL), 1.0),
        'g_mix_norm': 1.0 + nrm(ks[1], (DEPTH, D_MODEL), 0.02),
        'w_in': nrm(ks[2], (DEPTH, D_MODEL, IN_WIDTH), D_MODEL ** -0.5),
        'g_q': 1.0 + nrm(ks[3], (DEPTH, HEAD_DIM), 0.02),
        'g_k': 1.0 + nrm(ks[4], (DEPTH, N_BRANCH, HEAD_DIM), 0.02),
        'pe_cmp': nrm(ks[5], (DEPTH, 2, CMP_BLOCK, HEAD_DIM), 0.1),
        'w_cmp1': nrm(ks[6], (DEPTH, 2, CMP_BLOCK * HEAD_DIM, CMP_HIDDEN), (CMP_BLOCK * HEAD_DIM) ** -0.5),
        'b_cmp1': nrm(ks[7], (DEPTH, 2, CMP_HIDDEN), 0.01),
        'w_cmp2': nrm(ks[8], (DEPTH, 2, CMP_HIDDEN, HEAD_DIM), CMP_HIDDEN ** -0.5),
        'b_cmp2': nrm(ks[9], (DEPTH, 2, HEAD_DIM), 0.01),
        'conv_w': nrm(ks[10], (DEPTH, CONV_K, CONV_WIDTH), CONV_K ** -0.5),
        'g_out': 1.0 + nrm(ks[11], (DEPTH, D_MODEL), 0.02),
        'w_o': nrm(ks[12], (DEPTH, D_MODEL, D_MODEL), (2 * DEPTH * D_MODEL) ** -0.5),
        'g_ffn_norm': 1.0 + nrm(ks[13], (DEPTH, D_MODEL), 0.02),
        'w_up': nrm(ks[14], (DEPTH, D_MODEL, D_FF), D_MODEL ** -0.5),
        'w_down': nrm(ks[15], (DEPTH, D_FF, D_MODEL), (2 * DEPTH * D_FF) ** -0.5),
    }


def reference(x, g_mix_norm, w_in, g_q, g_k, pe_cmp, w_cmp1, b_cmp1, w_cmp2, b_cmp2,
              conv_w, g_out, w_o, g_ffn_norm, w_up, w_down):
    B, T = x.shape[0], x.shape[1]
    sizes = [ATTN_WIDTH] + [KV_WIDTH] * 6 + [N_BRANCH * N_ATTN_HEADS] + [CONV_WIDTH] * 3
    offs = [int(o) for o in np.cumsum(sizes)[:-1]]
    kv_shape = (B, T, N_KV_GROUPS, HEAD_DIM)
    for l in range(DEPTH):
        h = rms_norm(x, g_mix_norm[l])
        z = h @ w_in[l]
        q, kc, vc, ks_, vs_, kw_, vw_, gl, hc, cg, bg = jnp.split(z, offs, axis=-1)
        q = rms_norm(q.reshape(B, T, N_ATTN_HEADS, HEAD_DIM), g_q[l])
        k_cmp = rms_norm(compress(kc.reshape(kv_shape), pe_cmp[l, 0], w_cmp1[l, 0], b_cmp1[l, 0],
                                  w_cmp2[l, 0], b_cmp2[l, 0]), g_k[l, 0])
        v_cmp = compress(vc.reshape(kv_shape), pe_cmp[l, 1], w_cmp1[l, 1], b_cmp1[l, 1],
                         w_cmp2[l, 1], b_cmp2[l, 1])
        k_slc = rms_norm(ks_.reshape(kv_shape), g_k[l, 1])
        k_win = rms_norm(kw_.reshape(kv_shape), g_k[l, 2])
        gates = jax.nn.sigmoid(gl).reshape(B, T, N_ATTN_HEADS, N_BRANCH)
        attn_out = nsa_attention(q, k_cmp, v_cmp, k_slc, vs_.reshape(kv_shape),
                                 k_win, vw_.reshape(kv_shape), gates)
        conv_out = short_conv_mixer(hc, cg, bg, conv_w[l])
        mixed = jnp.concatenate([rms_norm(attn_out, g_out[l, :ATTN_WIDTH]),
                                 rms_norm(conv_out, g_out[l, ATTN_WIDTH:])], axis=-1)
        x = x + mixed @ w_o[l]
        h = rms_norm(x, g_ffn_norm[l])
        x = x + jnp.square(jax.nn.relu(h @ w_up[l])) @ w_down[l]
    return x
```

```cpp
#include <hip/hip_runtime.h>
#include <hip/hip_cooperative_groups.h>
#include <cstdio>
#include <cstdint>
namespace cg = cooperative_groups;
__device__ __forceinline__ int lane_mb() { unsigned z = 0u; asm volatile("" : "+v"(z)); return (int)__builtin_amdgcn_mbcnt_hi(~0u, __builtin_amdgcn_mbcnt_lo(~0u, z)); }
namespace pg8 {
#define PG8_LAS __attribute__((address_space(3)))
typedef unsigned short bf16_t;
typedef short bf16x8 __attribute__((ext_vector_type(8)));
typedef float f32x4 __attribute__((ext_vector_type(4)));
typedef unsigned u32x4 __attribute__((ext_vector_type(4)));
constexpr int BM = 256, BK = 64, HALF = 128, HTB = HALF * BK * 2  , STAGE_BYTES = 8 * HTB, NXCD = 8, WGM = 8;

__host__ __device__ __forceinline__ int lds_byte(int r, int c) { const int st = (r >> 4) * 2 + (c >> 5), rr = r & 15, cc = c & 31, ob = rr * 64 + cc * 2; return st * 1024 + (ob ^ (((ob >> 9) & 1) << 5)); }
__host__ __device__ __forceinline__ void stage_rc(int b, int& R, int& C) { const int st = b / 1024, sb = b % 1024, swz = sb ^ (((sb >> 9) & 1) << 5); R = (st >> 1) * 16 + swz / 64; C = (st & 1) * 32 + (swz % 64) / 2; }
__host__ __device__ __forceinline__ int perm32(int rho) { const int n = rho >> 4, i = rho & 15; return 8 * (i >> 2) + 4 * n + (i & 3); }

struct Unit { int pm, pn; };
struct Gemm { const bf16_t* A; const bf16_t* Bt; int M, N, K; };

struct StaticOrder {
    int nM, nN, nwg, G, c;
    __host__ __device__ void init(int M, int N, int G_, int c_) { nM = M / BM; nN = N / BM; nwg = nM * nN; G = G_; c = c_; }
    __host__ __device__ bool next(int i, Unit& u) const {
        const long L = (long)i * G + c; if (L >= nwg) return false;
        int wgid = (int)L; { const int q = nwg / NXCD, r = nwg % NXCD, xcd = wgid % NXCD, off = wgid / NXCD; wgid = (xcd < r ? xcd * (q + 1) : r * (q + 1) + (xcd - r) * q) + off; }
        const int nig = WGM * nN, gid = wgid / nig, fm = gid * WGM, gsz = (nM - fm) < WGM ? (nM - fm) : WGM;
        u.pm = fm + ((wgid % nig) % gsz); u.pn = (wgid % nig) / gsz; return true;
    }
    __device__ __forceinline__ void a_ready(const Unit&) const {}
    __device__ __forceinline__ void done(const Unit&) const {}
};
template <class Epi, class Sched, bool ALIGN_EPI = false, bool SP2 = false>
__device__ __forceinline__ void gemm_phase(PG8_LAS unsigned char* lds, const Gemm g, const Sched& S, const Epi& E, const int wave_in) {
    int tid_ = wave_in * 64 + lane_mb(); asm volatile("" : "+v"(tid_));
    const int tid = tid_, wid = __builtin_amdgcn_readfirstlane(tid >> 6), lane = tid & 63, wr = wid >> 2, wc = wid & 3, fr = lane & 15, fq = lane >> 4;
    const int K = g.K, nt = K / BK;
    unsigned voffA[2], voffB[2];
#pragma unroll
    for (int i = 0; i < 2; ++i) { int R, C; stage_rc(tid * 16 + i * 8192, R, C); const int Rb = Epi::PERM ? ((R & ~31) + perm32(R & 31)) : R;
        voffA[i] = (unsigned)(R * K + C) * 2u; voffB[i] = (unsigned)(Rb * K + C) * 2u; }
    const size_t kstep = (size_t)(BK * 2);
    const size_t hstep = (size_t)HALF * K * 2;
    const size_t tstep = 2 * hstep;
    const unsigned ldsw = (unsigned)wid * 1024u;
    const int aoff = lds_byte(wr * 64 + fr, fq * 8), boff = lds_byte(wc * 32 + fr, fq * 8);
#define PG8_SA(b, h) (((b) * 2 + (h)) * HTB)
#define PG8_SB(b, h) ((4 + (b) * 2 + (h)) * HTB)
#define PG8_STAGE(bufoff, gbase, voff) do { _Pragma("unroll") for (int _i = 0; _i < 2; ++_i) \
        __builtin_amdgcn_global_load_lds((const unsigned*)((const char*)(gbase) + (voff)[_i]), (PG8_LAS unsigned*)(lds + (bufoff) + ldsw + _i * 8192), 16, 0, 0); } while (0)
#define PG8_LDA(dst, b, h) do { _Pragma("unroll") for (int m = 0; m < 4; ++m) _Pragma("unroll") for (int k = 0; k < 2; ++k) dst[m][k] = *(const PG8_LAS bf16x8*)(lds + PG8_SA(b, h) + aoff + m * 2048 + k * 1024); } while (0)
#define PG8_LDB(dst, b, h) do { _Pragma("unroll") for (int n = 0; n < 2; ++n) _Pragma("unroll") for (int k = 0; k < 2; ++k) dst[n][k] = *(const PG8_LAS bf16x8*)(lds + PG8_SB(b, h) + boff + n * 2048 + k * 1024); } while (0)
#define PG8_MMA(ai, bj, At, Bt) do { __builtin_amdgcn_s_setprio(1); _Pragma("unroll") for (int m = 0; m < 4; ++m) _Pragma("unroll") for (int n = 0; n < 2; ++n) _Pragma("unroll") for (int k = 0; k < 2; ++k) \
        acc[ai][bj][m][n] = __builtin_amdgcn_mfma_f32_16x16x32_bf16(Bt[n][k], At[m][k], acc[ai][bj][m][n], 0, 0, 0); __builtin_amdgcn_s_setprio(0); } while (0)
#define PG8_WAIT_V(n) asm volatile("s_waitcnt vmcnt(" #n ")" ::: "memory")
#define PG8_WAIT_L(n) asm volatile("s_waitcnt lgkmcnt(" #n ")" ::: "memory")
#define PG8_BAR __builtin_amdgcn_s_barrier()
#define PG8_SCHED __builtin_amdgcn_sched_barrier(0)
    Unit cur, nxt; int ui = 0;
    if (!S.next(0, cur)) return;
    f32x4 acc[2][2][4][2];
#pragma unroll
    for (int a = 0; a < 2; ++a)
#pragma unroll
        for (int b = 0; b < 2; ++b)
#pragma unroll
            for (int m = 0; m < 4; ++m)
#pragma unroll
                for (int n = 0; n < 2; ++n) acc[a][b][m][n] = (f32x4){0.f, 0.f, 0.f, 0.f};
    bf16x8 At[4][2], B0[2][2], B1[2][2];
    const char* cA = (const char*)g.A + (size_t)cur.pm * tstep; const char* cB = (const char*)g.Bt + (size_t)cur.pn * tstep;
    S.a_ready(cur);
    if constexpr (SP2) {
        PG8_STAGE(PG8_SB(0, 0), cB, voffB); PG8_STAGE(PG8_SB(0, 1), cB + hstep, voffB); PG8_STAGE(PG8_SA(0, 0), cA, voffA); PG8_STAGE(PG8_SA(0, 1), cA + hstep, voffA);
        if (wr == 1) PG8_BAR;
        PG8_WAIT_V(2); PG8_BAR;
        PG8_STAGE(PG8_SB(1, 0), cB + kstep, voffB); PG8_STAGE(PG8_SA(1, 0), cA + kstep, voffA); PG8_STAGE(PG8_SB(1, 1), cB + hstep + kstep, voffB);
        PG8_WAIT_V(6); PG8_BAR;
    } else {
        PG8_STAGE(PG8_SB(0, 0), cB, voffB); PG8_STAGE(PG8_SA(0, 0), cA, voffA); PG8_STAGE(PG8_SB(0, 1), cB + hstep, voffB); PG8_STAGE(PG8_SA(0, 1), cA + hstep, voffA);
        if (wr == 1) PG8_BAR;
        PG8_WAIT_V(4); PG8_BAR;
        PG8_STAGE(PG8_SB(1, 0), cB + kstep, voffB); PG8_STAGE(PG8_SA(1, 0), cA + kstep, voffA); PG8_STAGE(PG8_SB(1, 1), cB + hstep + kstep, voffB);
        PG8_WAIT_V(6); PG8_BAR;
    }
    for (;;) {
        const bool has_next = S.next(ui + 1, nxt);
        const char* nA = has_next ? (const char*)g.A + (size_t)nxt.pm * tstep : cA; const char* nB = has_next ? (const char*)g.Bt + (size_t)nxt.pn * tstep : cB;
        for (int t = 0; t < nt; t += 2) {
            const bool last = (t == nt - 2);
            const char* a1 = cA + (size_t)(t + 1) * kstep;
            const char* a2 = last ? nA : cA + (size_t)(t + 2) * kstep; const char* b2 = last ? nB : cB + (size_t)(t + 2) * kstep;
            const char* a3 = a2 + kstep; const char* b3 = b2 + kstep;
            if (last && has_next) S.a_ready(nxt);
            if constexpr (SP2) {
            PG8_LDB(B0, 0, 0); PG8_LDB(B1, 0, 1); PG8_SCHED; PG8_LDA(At, 0, 0); PG8_STAGE(PG8_SA(1, 1), a1 + hstep, voffA);
            PG8_WAIT_V(8); PG8_WAIT_L(0); PG8_BAR; PG8_MMA(0, 0, At, B0); PG8_MMA(0, 1, At, B1); PG8_BAR; PG8_SCHED;
            PG8_LDA(At, 0, 1); PG8_STAGE(PG8_SB(0, 0), b2, voffB); PG8_STAGE(PG8_SB(0, 1), b2 + hstep, voffB); PG8_STAGE(PG8_SA(0, 0), a2, voffA);
            PG8_WAIT_V(8); PG8_WAIT_L(0); PG8_BAR; PG8_MMA(1, 0, At, B0); PG8_MMA(1, 1, At, B1); PG8_BAR; PG8_SCHED;
            PG8_LDB(B0, 1, 0); PG8_LDB(B1, 1, 1); PG8_SCHED; PG8_LDA(At, 1, 0); PG8_STAGE(PG8_SA(0, 1), a2 + hstep, voffA);
            PG8_WAIT_V(8); PG8_WAIT_L(0); PG8_BAR; PG8_MMA(0, 0, At, B0); PG8_MMA(0, 1, At, B1); PG8_BAR; PG8_SCHED;
            PG8_LDA(At, 1, 1); PG8_STAGE(PG8_SB(1, 0), b3, voffB); PG8_STAGE(PG8_SB(1, 1), b3 + hstep, voffB); PG8_STAGE(PG8_SA(1, 0), a3, voffA);
            PG8_WAIT_V(8); PG8_WAIT_L(0); PG8_BAR; PG8_MMA(1, 0, At, B0); PG8_MMA(1, 1, At, B1); PG8_BAR; PG8_SCHED;
            } else {
            PG8_LDB(B0, 0, 0); PG8_SCHED; PG8_LDA(At, 0, 0); PG8_STAGE(PG8_SA(1, 1), a1 + hstep, voffA);
            PG8_WAIT_L(8); PG8_BAR; PG8_WAIT_L(0); PG8_MMA(0, 0, At, B0); PG8_BAR; PG8_SCHED;
            PG8_LDB(B1, 0, 1); PG8_STAGE(PG8_SB(0, 0), b2, voffB);
            PG8_BAR; PG8_WAIT_L(0); PG8_MMA(0, 1, At, B1); PG8_BAR;
            PG8_LDA(At, 0, 1); PG8_STAGE(PG8_SA(0, 0), a2, voffA);
            PG8_BAR; PG8_WAIT_L(0); PG8_MMA(1, 0, At, B0); PG8_BAR; PG8_SCHED;
            PG8_STAGE(PG8_SB(0, 1), b2 + hstep, voffB);
            PG8_WAIT_V(6); PG8_BAR; PG8_MMA(1, 1, At, B1); PG8_BAR;
            PG8_LDB(B0, 1, 0); PG8_SCHED; PG8_LDA(At, 1, 0); PG8_STAGE(PG8_SA(0, 1), a2 + hstep, voffA);
            PG8_WAIT_L(8); PG8_BAR; PG8_WAIT_L(0); PG8_MMA(0, 0, At, B0); PG8_BAR; PG8_SCHED;
            PG8_LDB(B1, 1, 1); PG8_STAGE(PG8_SB(1, 0), b3, voffB);
            PG8_BAR; PG8_WAIT_L(0); PG8_MMA(0, 1, At, B1); PG8_BAR;
            PG8_LDA(At, 1, 1); PG8_STAGE(PG8_SA(1, 0), a3, voffA);
            PG8_BAR; PG8_WAIT_L(0); PG8_MMA(1, 0, At, B0); PG8_BAR; PG8_SCHED;
            PG8_STAGE(PG8_SB(1, 1), b3 + hstep, voffB);
            PG8_WAIT_V(6); PG8_BAR; PG8_MMA(1, 1, At, B1); PG8_BAR;
            }
        }
        if constexpr (ALIGN_EPI) { if (wr == 0) PG8_BAR; }
        if constexpr (!Epi::AFTER_DRAIN) { E(acc, cur, wr, wc, fr, fq); S.done(cur); }
        if (!has_next) break;
#pragma unroll
        for (int a = 0; a < 2; ++a)
#pragma unroll
            for (int b = 0; b < 2; ++b)
#pragma unroll
                for (int m = 0; m < 4; ++m)
#pragma unroll
                    for (int n = 0; n < 2; ++n) acc[a][b][m][n] = (f32x4){0.f, 0.f, 0.f, 0.f};
        cur = nxt; cA = nA; cB = nB; ++ui;
        if constexpr (ALIGN_EPI) { if (wr == 1) PG8_BAR; }
    }
    PG8_WAIT_V(0);
    if constexpr (!ALIGN_EPI) { if (wr == 0) PG8_BAR; }
    PG8_BAR;
    if constexpr (Epi::AFTER_DRAIN) { E.fused(acc, cur, wr, wc, fr, fq, lds, wid, lane); S.done(cur); }
#undef PG8_SA
#undef PG8_SB
#undef PG8_STAGE
#undef PG8_LDA
#undef PG8_LDB
#undef PG8_MMA
#undef PG8_WAIT_V
#undef PG8_WAIT_L
#undef PG8_BAR
#undef PG8_SCHED
}
}

#define DI __device__ __forceinline__
#define LAS __attribute__((address_space(3)))
typedef unsigned short bf16_t;
typedef short bf16x8 __attribute__((ext_vector_type(8)));
typedef float f32x4 __attribute__((ext_vector_type(4)));
typedef float f32x16 __attribute__((ext_vector_type(16)));
typedef unsigned u32x4 __attribute__((ext_vector_type(4)));
typedef unsigned u32x2 __attribute__((ext_vector_type(2)));
typedef float f32x2_t __attribute__((ext_vector_type(2)));
typedef __bf16 bf16x2_t __attribute__((ext_vector_type(2)));

constexpr int T_ = 16384, M_ = 32768, DM = 1024, NIN = 3072, DFF = 4096, DEPTH_ = 4;
constexpr float EPS_ = 1e-6f, LOG2E_ = 1.4426950408889634f;
constexpr size_t MiB = 1u << 20;
constexpr size_t WS_B1PART = 0, WS_B1P = 512 * 1024, WS_BAR = 1 * MiB  , WS_SSPA = 2 * MiB, WS_SSPB = 4 * MiB;
constexpr size_t WS_WIN = 8 * MiB, WS_WO = 32 * MiB, WS_WUP = 40 * MiB, WS_WDN = 72 * MiB, WS_W1T = 104 * MiB, WS_W2T = 112 * MiB;
constexpr size_t WS_KCMP = 114 * MiB, WS_VCMPT = 115 * MiB, WS_GATE = 116 * MiB, WS_XB = 120 * MiB, WS_H = 184 * MiB;
constexpr size_t WS_Q = 184 * MiB, WS_KC = 216 * MiB, WS_VC = 224 * MiB, WS_KS = 232 * MiB, WS_KW = 240 * MiB, WS_VST = 248 * MiB, WS_VWT = 256 * MiB,
                 WS_U = 264 * MiB, WS_BG = 296 * MiB, WS_MIXED = 328 * MiB, WS_OGP = 392 * MiB  , WS_END = 488 * MiB;
constexpr int LDS_BYTES = 163840, AL_BARST = 163776;

DI unsigned pk2(float lo, float hi) { f32x2_t v = {lo, hi}; bf16x2_t b = __builtin_convertvector(v, bf16x2_t); return __builtin_bit_cast(unsigned, b); }
DI float bflo(unsigned w) { return __uint_as_float(w << 16); }
DI float bfhi(unsigned w) { return __uint_as_float(w & 0xffff0000u); }
DI float fexp2(float x) { return __builtin_amdgcn_exp2f(x); }
DI float frcp(float x) { return __builtin_amdgcn_rcpf(x); }
#define MFMA32(a, b, c) __builtin_amdgcn_mfma_f32_32x32x16_bf16((a), (b), (c), 0, 0, 0)
#define MFMA16(a, b, c) __builtin_amdgcn_mfma_f32_16x16x32_bf16((a), (b), (c), 0, 0, 0)

DI float dpp_f(float v, const int ctrl) { return v; }
#define DPPF(v, ctrl) __builtin_bit_cast(float, __builtin_amdgcn_mov_dpp(__builtin_bit_cast(int, (float)(v)), (ctrl), 0xF, 0xF, true))
#define DPPU(v, ctrl) ((unsigned)__builtin_amdgcn_mov_dpp((int)(v), (ctrl), 0xF, 0xF, true))
DI float sx1(float v) { return v + DPPF(v, 0xB1); }
DI float sx2(float v) { return v + DPPF(v, 0x4E); }
DI float sx16(float v) { const unsigned u = __float_as_uint(v); auto r = __builtin_amdgcn_permlane16_swap(u, u, false, false); return __uint_as_float(r[0]) + __uint_as_float(r[1]); }
DI float sx32(float v) { const unsigned u = __float_as_uint(v); auto r = __builtin_amdgcn_permlane32_swap(u, u, false, false); return __uint_as_float(r[0]) + __uint_as_float(r[1]); }
DI void lds_fence() { asm volatile("s_waitcnt lgkmcnt(0)" ::: "memory"); __builtin_amdgcn_wave_barrier(); }

DI float row_rstd(const float* ssp, int row) {
    const f32x4* p = (const f32x4*)(ssp + (size_t)row * 16);
    const f32x4 a = p[0], b = p[1], c = p[2], d = p[3];
    const float s = ((a.x + a.y) + (a.z + a.w)) + ((b.x + b.y) + (b.z + b.w)) + ((c.x + c.y) + (c.z + c.w)) + ((d.x + d.y) + (d.z + d.w));
    return rsqrtf(s * (1.0f / 1024.0f) + EPS_);
}

DI void row_rstd8(float (&rs)[2][4], const float* ssp, const int rbase, const int fq) {
    f32x4 v[2][4];
#pragma unroll
    for (int ai = 0; ai < 2; ++ai)
#pragma unroll
        for (int m = 0; m < 4; ++m) v[ai][m] = *(const f32x4*)(ssp + (size_t)(rbase + ai * 128 + m * 16) * 16 + 4 * fq);
#pragma unroll
    for (int ai = 0; ai < 2; ++ai)
#pragma unroll
        for (int m = 0; m < 4; ++m) { float t = (v[ai][m].x + v[ai][m].y) + (v[ai][m].z + v[ai][m].w); t = sx16(t); t = sx32(t); rs[ai][m] = rsqrtf(t * (1.0f / 1024.0f) + EPS_); }
}

struct EpiIn {
    static constexpr bool PERM = true, AFTER_DRAIN = false;
    unsigned char* ws; const float *gq, *gk; float qscale;
    __device__ __forceinline__ void operator()(const f32x4 (&acc)[2][2][4][2], const pg8::Unit& u, int wr, int wc, int fr_, int fq_) const {
        int fr = fr_, fq = fq_; asm volatile("" : "+v"(fr), "+v"(fq));
        const float* ssp = (const float*)(ws + WS_SSPA);
        bf16_t* const Q = (bf16_t*)(ws + WS_Q); bf16_t* const KC = (bf16_t*)(ws + WS_KC); bf16_t* const VC = (bf16_t*)(ws + WS_VC); bf16_t* const KS = (bf16_t*)(ws + WS_KS); bf16_t* const KW = (bf16_t*)(ws + WS_KW);
        bf16_t* const VST = (bf16_t*)(ws + WS_VST); bf16_t* const VWT = (bf16_t*)(ws + WS_VWT); bf16_t* const U = (bf16_t*)(ws + WS_U); bf16_t* const BG = (bf16_t*)(ws + WS_BG); float* const GATE = (float*)(ws + WS_GATE);
        const int pn = u.pn;
        const int rbase = u.pm * 256 + wr * 64 + fr;
        float rs8[2][4]; row_rstd8(rs8, ssp, rbase, fq);
        if (pn < 2 || ((pn == 3 || pn == 4) && wc < 2)) {
            const float* g = (pn < 2) ? gq : gk + (pn == 3 ? 64 : 128);
            const float sc = (pn < 2) ? qscale : 1.0f;
            f32x4 gv[2][2];
#pragma unroll
            for (int bj = 0; bj < 2; ++bj)
#pragma unroll
                for (int n = 0; n < 2; ++n) gv[bj][n] = *(const f32x4*)(g + 32 * bj + 8 * fq + 4 * n);
            bf16_t* dst; int ld, cofs;
            if (pn < 2) { dst = Q; ld = 512; cofs = (pn * 4 + wc) * 64; } else { dst = (pn == 3) ? KS : KW; ld = 128; cofs = wc * 64; }
#pragma unroll
            for (int ai = 0; ai < 2; ++ai)
#pragma unroll
                for (int m = 0; m < 4; ++m) {
                    const int row = rbase + ai * 128 + m * 16; const float rs = rs8[ai][m];
                    f32x4 v[2][2]; float ss = 0.f;
#pragma unroll
                    for (int bj = 0; bj < 2; ++bj)
#pragma unroll
                        for (int n = 0; n < 2; ++n) { v[bj][n] = acc[ai][bj][m][n] * rs; const f32x4 q = v[bj][n] * v[bj][n]; ss += (q.x + q.y) + (q.z + q.w); }
                    ss = sx16(ss); ss = sx32(ss);
                    const float r2 = rsqrtf(ss * (1.0f / 64.0f) + EPS_) * sc;
#pragma unroll
                    for (int bj = 0; bj < 2; ++bj) {
                        const f32x4 a = v[bj][0] * gv[bj][0] * r2, b = v[bj][1] * gv[bj][1] * r2;
                        u32x4 w; w.x = pk2(a.x, a.y); w.y = pk2(a.z, a.w); w.z = pk2(b.x, b.y); w.w = pk2(b.z, b.w);
                        *(u32x4*)(dst + (size_t)row * ld + cofs + 32 * bj + 8 * fq) = w;
                    }
                }
        } else if (pn == 2) {
            bf16_t* dst = (wc < 2) ? KC : VC; const int cofs = (wc & 1) * 64;
#pragma unroll
            for (int ai = 0; ai < 2; ++ai)
#pragma unroll
                for (int m = 0; m < 4; ++m) {
                    const int row = rbase + ai * 128 + m * 16; const float rs = rs8[ai][m];
#pragma unroll
                    for (int bj = 0; bj < 2; ++bj) {
                        const f32x4 a = acc[ai][bj][m][0] * rs, b = acc[ai][bj][m][1] * rs;
                        u32x4 w; w.x = pk2(a.x, a.y); w.y = pk2(a.z, a.w); w.z = pk2(b.x, b.y); w.w = pk2(b.z, b.w);
                        *(u32x4*)(dst + (size_t)row * 128 + cofs + 32 * bj + 8 * fq) = w;
                    }
                }
        } else if (pn == 3 || pn == 4) {
            bf16_t* dst = (pn == 3) ? VST : VWT; const int g = wc & 1;
#pragma unroll
            for (int ai = 0; ai < 2; ++ai)
#pragma unroll
                for (int m = 0; m < 4; ++m) {
                    const int row = rbase + ai * 128 + m * 16; const float rs = rs8[ai][m];
                    const int b = row >> 14, t = row & (T_ - 1);
                    bf16_t* base = dst + (size_t)((b * 2 + g) * 64) * T_ + t;
#pragma unroll
                    for (int bj = 0; bj < 2; ++bj)
#pragma unroll
                        for (int n = 0; n < 2; ++n) {
                            const f32x4 a = acc[ai][bj][m][n] * rs; const int d0 = 32 * bj + 8 * fq + 4 * n;
                            const unsigned w0 = pk2(a.x, a.y), w1 = pk2(a.z, a.w);
                            base[(size_t)(d0 + 0) * T_] = (bf16_t)(w0 & 0xffff); base[(size_t)(d0 + 1) * T_] = (bf16_t)(w0 >> 16);
                            base[(size_t)(d0 + 2) * T_] = (bf16_t)(w1 & 0xffff); base[(size_t)(d0 + 3) * T_] = (bf16_t)(w1 >> 16);
                        }
                }
        } else if (pn < 9) {
            const int cofs = 128 * (pn - 5) + 32 * wc + 8 * fq;
#pragma unroll
            for (int ai = 0; ai < 2; ++ai)
#pragma unroll
                for (int m = 0; m < 4; ++m) {
                    const int row = rbase + ai * 128 + m * 16; const float rs = rs8[ai][m]; const float r2 = rs * rs;
                    const f32x4 a = acc[ai][0][m][0] * acc[ai][1][m][0] * r2, b = acc[ai][0][m][1] * acc[ai][1][m][1] * r2;
                    u32x4 w; w.x = pk2(a.x, a.y); w.y = pk2(a.z, a.w); w.z = pk2(b.x, b.y); w.w = pk2(b.z, b.w);
                    *(u32x4*)(U + (size_t)row * 512 + cofs) = w;
                }
        } else if (pn < 11) {
#pragma unroll
            for (int ai = 0; ai < 2; ++ai)
#pragma unroll
                for (int m = 0; m < 4; ++m) {
                    const int row = rbase + ai * 128 + m * 16; const float rs = rs8[ai][m];
#pragma unroll
                    for (int bj = 0; bj < 2; ++bj) {
                        const f32x4 a = acc[ai][bj][m][0] * rs, b = acc[ai][bj][m][1] * rs;
                        u32x4 w; w.x = pk2(a.x, a.y); w.y = pk2(a.z, a.w); w.z = pk2(b.x, b.y); w.w = pk2(b.z, b.w);
                        *(u32x4*)(BG + (size_t)row * 512 + 256 * (pn - 9) + 128 * bj + 32 * wc + 8 * fq) = w;
                    }
                }
        } else {
            if (wc == 0 && fq < 3) {
#pragma unroll
                for (int ai = 0; ai < 2; ++ai)
#pragma unroll
                    for (int m = 0; m < 4; ++m) {
                        const int row = rbase + ai * 128 + m * 16; const float rs = rs8[ai][m];
#pragma unroll
                        for (int n = 0; n < 2; ++n) {
                            const f32x4 a = acc[ai][0][m][n] * rs; f32x4 o;
                            o.x = frcp(1.0f + fexp2(-a.x * LOG2E_)); o.y = frcp(1.0f + fexp2(-a.y * LOG2E_));
                            o.z = frcp(1.0f + fexp2(-a.z * LOG2E_)); o.w = frcp(1.0f + fexp2(-a.w * LOG2E_));
                            *(f32x4*)(GATE + (size_t)row * 24 + 8 * fq + 4 * n) = o;
                        }
                    }
            }
        }
    }
};

struct EpiRes {
    static constexpr bool PERM = true, AFTER_DRAIN = false;
    const float* Xin; float* X; bf16_t* XB; float* ssp_out;
    __device__ __forceinline__ void operator()(const f32x4 (&acc)[2][2][4][2], const pg8::Unit& u, int wr, int wc, int fr_, int fq_) const {
        int fr = fr_, fq = fq_; asm volatile("" : "+v"(fr), "+v"(fq));
        const int rbase = u.pm * 256 + wr * 64 + fr, cbase = u.pn * 256 + wc * 32 + 8 * fq;
#pragma unroll
        for (int ai = 0; ai < 2; ++ai) {
            f32x4 xv[4][2][2];
#pragma unroll
            for (int m = 0; m < 4; ++m)
#pragma unroll
                for (int bj = 0; bj < 2; ++bj) { const float* xp = Xin + (size_t)(rbase + ai * 128 + m * 16) * DM + cbase + 128 * bj; xv[m][bj][0] = *(const f32x4*)xp; xv[m][bj][1] = *(const f32x4*)(xp + 4); }
#pragma unroll
            for (int m = 0; m < 4; ++m) {
                const int row = rbase + ai * 128 + m * 16; float ss = 0.f;
#pragma unroll
                for (int bj = 0; bj < 2; ++bj) {
                    float* xp = X + (size_t)row * DM + cbase + 128 * bj;
                    const f32x4 a = xv[m][bj][0] + acc[ai][bj][m][0], b = xv[m][bj][1] + acc[ai][bj][m][1];
                    __builtin_nontemporal_store(a, (f32x4*)xp); __builtin_nontemporal_store(b, (f32x4*)(xp + 4));
                    u32x4 w; w.x = pk2(a.x, a.y); w.y = pk2(a.z, a.w); w.z = pk2(b.x, b.y); w.w = pk2(b.z, b.w);
                    *(u32x4*)(XB + (size_t)row * DM + cbase + 128 * bj) = w;
                    const f32x4 qa = a * a, qb = b * b; ss += ((qa.x + qa.y) + (qa.z + qa.w)) + ((qb.x + qb.y) + (qb.z + qb.w));
                }
                ss = sx16(ss); ss = sx32(ss);
                if (fq == 0) ssp_out[(size_t)row * 16 + u.pn * 4 + wc] = ss;
            }
        }
    }
};

struct EpiUp {
    static constexpr bool PERM = true, AFTER_DRAIN = false;
    const float* ssp; bf16_t* H;
    __device__ __forceinline__ void operator()(const f32x4 (&acc)[2][2][4][2], const pg8::Unit& u, int wr, int wc, int fr_, int fq_) const {
        int fr = fr_, fq = fq_; asm volatile("" : "+v"(fr), "+v"(fq));
        const int rbase = u.pm * 256 + wr * 64 + fr, cbase = u.pn * 256 + wc * 32 + 8 * fq;
        float rs8[2][4]; row_rstd8(rs8, ssp, rbase, fq);
#pragma unroll
        for (int ai = 0; ai < 2; ++ai)
#pragma unroll
            for (int m = 0; m < 4; ++m) {
                const int row = rbase + ai * 128 + m * 16; const float rs = rs8[ai][m];
#pragma unroll
                for (int bj = 0; bj < 2; ++bj) {
                    f32x4 a = acc[ai][bj][m][0] * rs, b = acc[ai][bj][m][1] * rs;
                    a = __builtin_elementwise_max(a, (f32x4){0.f, 0.f, 0.f, 0.f}); b = __builtin_elementwise_max(b, (f32x4){0.f, 0.f, 0.f, 0.f});
                    a = a * a; b = b * b;
                    u32x4 w; w.x = pk2(a.x, a.y); w.y = pk2(a.z, a.w); w.z = pk2(b.x, b.y); w.w = pk2(b.z, b.w);
                    *(u32x4*)(H + (size_t)row * DFF + cbase + 128 * bj) = w;
                }
            }
    }
};

DI int win_src_col(int np) {
    const int tile = np >> 8, ct = np & 255, bj = ct >> 7, wc = (ct >> 5) & 3, w = ct & 31, d = 32 * bj + w;
    if (tile < 2) return (tile * 4 + wc) * 64 + d;
    if (tile < 5) return 512 + (tile - 2) * 256 + wc * 64 + d;
    if (tile < 9) return (bj ? 1816 : 1304) + 128 * (tile - 5) + (ct & 127);
    if (tile < 11) return 2328 + 256 * (tile - 9) + ct;
    return ct < 24 ? 1280 + ct : -1;
}
template <bool MAP> DI void tr_item(const float* W, int K, int N, bf16_t* WT, const float* gs, LAS float* scr, int kb, int nb, int lane) {
    const int k0 = 64 * kb, n0 = 32 * nb;
    const int np = n0 + (lane & 31); const int col = MAP ? win_src_col(np) : np;
    float tv[32];
#pragma unroll
    for (int i = 0; i < 32; ++i) { const int kk = 2 * i + (lane >> 5); tv[i] = (col >= 0) ? W[(size_t)(k0 + kk) * N + col] : 0.f; }
    if (gs) {
        const float g0 = gs[k0 + (lane >> 5) + 2 * (lane & 31)];
#pragma unroll
        for (int i = 0; i < 32; ++i) tv[i] *= __builtin_bit_cast(float, __builtin_amdgcn_ds_bpermute(4 * (i + (lane & 32)), __builtin_bit_cast(int, g0)));
    }
#pragma unroll
    for (int i = 0; i < 32; ++i) scr[(2 * i + (lane >> 5)) * 33 + (lane & 31)] = tv[i];
    lds_fence();
    const int c = lane & 7;
#pragma unroll
    for (int j = 0; j < 4; ++j) {
        const int n = (lane >> 3) + 8 * j; const LAS float* s = scr + (8 * c) * 33 + n;
        u32x4 o; o.x = pk2(s[0 * 33], s[1 * 33]); o.y = pk2(s[2 * 33], s[3 * 33]); o.z = pk2(s[4 * 33], s[5 * 33]); o.w = pk2(s[6 * 33], s[7 * 33]);
        *(u32x4*)(WT + (size_t)(n0 + n) * K + k0 + 8 * c) = o;
    }
    lds_fence();
}

struct Params {
    const float *x, *g_mix, *w_in, *g_q, *g_k, *pe, *w1, *b1, *w2, *b2, *convw, *g_out, *w_o, *g_ffn, *w_up, *w_dn;
    float* out; unsigned char* ws;
};

DI float wave_sum(float v) { v += DPPF(v, 0xB1); v += DPPF(v, 0x4E); v += DPPF(v, 0x141); v += DPPF(v, 0x140); v = sx16(v); return sx32(v); }
DI unsigned wave_maxu(unsigned v) {
    unsigned w = DPPU(v, 0xB1); v = v > w ? v : w; w = DPPU(v, 0x4E); v = v > w ? v : w; w = DPPU(v, 0x141); v = v > w ? v : w; w = DPPU(v, 0x140); v = v > w ? v : w;
    { auto r = __builtin_amdgcn_permlane16_swap(v, v, false, false); v = r[0] > r[1] ? r[0] : r[1]; }
    { auto r = __builtin_amdgcn_permlane32_swap(v, v, false, false); v = r[0] > r[1] ? r[0] : r[1]; }
    return v;
}
DI float wave_maxf(float v) {
    v = fmaxf(v, DPPF(v, 0xB1)); v = fmaxf(v, DPPF(v, 0x4E)); v = fmaxf(v, DPPF(v, 0x141)); v = fmaxf(v, DPPF(v, 0x140));
    { const unsigned u = __float_as_uint(v); auto r = __builtin_amdgcn_permlane16_swap(u, u, false, false); v = fmaxf(__uint_as_float(r[0]), __uint_as_float(r[1])); }
    { const unsigned u = __float_as_uint(v); auto r = __builtin_amdgcn_permlane32_swap(u, u, false, false); v = fmaxf(__uint_as_float(r[0]), __uint_as_float(r[1])); }
    return v;
}

DI void p0_prep(const Params& p, LAS unsigned char* lds, int gw, int ngw, int wave, int lane) {
    unsigned char* ws = p.ws;
    LAS float* scr = (LAS float*)(lds + wave * 8704);
    constexpr int I_WIN = 16 * 96, I_WO = 16 * 32, I_WUP = 16 * 128, I_WDN = 64 * 32, I_W1 = 32 * 8, I_W2 = 4 * 2;
    constexpr int PER_L = I_WIN + I_WO + I_WUP + I_WDN + 2 * I_W1 + 2 * I_W2;
    for (int it = gw; it < DEPTH_ * PER_L; it += ngw) {
        const int l = it / PER_L; int r = it % PER_L;
        if (r < I_WIN) { tr_item<true>(p.w_in + (size_t)l * DM * 2840, DM, 2840, (bf16_t*)(ws + WS_WIN) + (size_t)l * NIN * DM, p.g_mix + l * DM, scr, r / 96, r % 96, lane); continue; } r -= I_WIN;
        if (r < I_WO) { tr_item<false>(p.w_o + (size_t)l * DM * DM, DM, DM, (bf16_t*)(ws + WS_WO) + (size_t)l * DM * DM, p.g_out + l * DM, scr, r / 32, r % 32, lane); continue; } r -= I_WO;
        if (r < I_WUP) { tr_item<false>(p.w_up + (size_t)l * DM * DFF, DM, DFF, (bf16_t*)(ws + WS_WUP) + (size_t)l * DFF * DM, p.g_ffn + l * DM, scr, r / 128, r % 128, lane); continue; } r -= I_WUP;
        if (r < I_WDN) { tr_item<false>(p.w_dn + (size_t)l * DFF * DM, DFF, DM, (bf16_t*)(ws + WS_WDN) + (size_t)l * DM * DFF, nullptr, scr, r / 32, r % 32, lane); continue; } r -= I_WDN;
        if (r < 2 * I_W1) { const int kv = r / I_W1, q = r % I_W1; tr_item<false>(p.w1 + (size_t)(l * 2 + kv) * 2048 * 256, 2048, 256, (bf16_t*)(ws + WS_W1T) + (size_t)(l * 2 + kv) * 256 * 2048, nullptr, scr, q / 8, q % 8, lane); continue; } r -= 2 * I_W1;
        { const int kv = r / I_W2, q = r % I_W2; tr_item<false>(p.w2 + (size_t)(l * 2 + kv) * 256 * 64, 256, 64, (bf16_t*)(ws + WS_W2T) + (size_t)(l * 2 + kv) * 64 * 256, nullptr, scr, q / 2, q % 2, lane); }
    }
    bf16_t* XB = (bf16_t*)(ws + WS_XB); float* sspa = (float*)(ws + WS_SSPA);
    for (int m = gw; m < M_; m += ngw) {
        const f32x4* xr = (const f32x4*)(p.x + (size_t)m * DM) + lane;
        u32x2* xb = (u32x2*)(XB + (size_t)m * DM) + lane;
        f32x4 v[4];
#pragma unroll
        for (int j = 0; j < 4; ++j) v[j] = xr[64 * j];
        float s = 0.f;
#pragma unroll
        for (int j = 0; j < 4; ++j) { u32x2 w; w.x = pk2(v[j].x, v[j].y); w.y = pk2(v[j].z, v[j].w); xb[64 * j] = w; s += (v[j].x * v[j].x + v[j].y * v[j].y) + (v[j].z * v[j].z + v[j].w * v[j].w); }
        s = wave_sum(s);
        if (lane < 16) sspa[(size_t)m * 16 + lane] = (lane == 0) ? s : 0.f;
    }
    float* b1part = (float*)(ws + WS_B1PART);
    for (int it = blockIdx.x; it < 256; it += gridDim.x) {
        const int lk = it >> 5, kc = it & 31, tid = wave * 64 + lane;
        if (tid < 256) {
            const float* w = p.w1 + (size_t)lk * 2048 * 256 + (size_t)(kc * 64) * 256 + tid; const float* pe = p.pe + lk * 2048 + kc * 64;
            float a = (kc == 0) ? p.b1[lk * 256 + tid] : 0.f;
#pragma unroll 8
            for (int k = 0; k < 64; ++k) a += pe[k] * w[(size_t)k * 256];
            b1part[(size_t)it * 256 + tid] = a;
        }
    }
}

DI float gelu_tanh(float x) {
    const float u = 1.5957691216f * (x + 0.044715f * x * x * x);
    return x * frcp(1.0f + fexp2(-u * LOG2E_));
}
DI void compress_wg_unit(const Params& p, int l, int unit, LAS unsigned char* L, int wave, int lane) {
    unsigned char* ws = p.ws;
    const int rtp = unit & 31, g = (unit >> 5) & 1, b = (unit >> 6) & 1, kv = unit >> 7;
    const int rg = wave >> 2, c4 = wave & 3;
    const int fr = lane & 15, fq = lane >> 4, i0 = (rtp * 2 + rg) * 16, i = i0 + fr;
    f32x4 acc[4];
#pragma unroll
    for (int c = 0; c < 4; ++c) acc[c] = (f32x4){0.f, 0.f, 0.f, 0.f};
    {
        const bf16_t* w1base = (const bf16_t*)(ws + WS_W1T) + (size_t)(l * 2 + kv) * 256 * 2048;
        const bf16_t* gsrc[4];
#pragma unroll
        for (int q4 = 0; q4 < 4; ++q4) { const int blk = wave * 4 + q4, c4p = blk >> 3, cp = (blk >> 1) & 3, kkp = blk & 1; gsrc[q4] = w1base + (size_t)(64 * c4p + 16 * cp + fr) * 2048 + 32 * kkp + 8 * fq; }
        const int ab = wave & 3;
        const bf16_t* asrc = (const bf16_t*)(ws + (kv ? WS_VC : WS_KC)) + ((size_t)(b * T_ + 16 * ((rtp * 2 + (ab >> 1)) * 16 + fr)) * 128 + g * 64 + 8 * fq) + 32 * (ab & 1);
        constexpr int CST_B = 36864;
        const int rot = (blockIdx.x >> 3) & 31;
#define CMP_ISSUE(st_) do { const int s_ = (((st_) < 32 ? (st_) : 0) + rot) & 31; LAS unsigned char* sp_ = L + ((st_) & 3) * CST_B; _Pragma("unroll") for (int q4 = 0; q4 < 4; ++q4) \
            __builtin_amdgcn_global_load_lds((const unsigned*)(gsrc[q4] + 64 * s_), (LAS unsigned*)(sp_ + (wave * 4 + q4) * 1024), 16, 0, 0); \
            __builtin_amdgcn_global_load_lds((const unsigned*)(asrc + 128 * s_), (LAS unsigned*)(sp_ + 32768 + ab * 1024), 16, 0, 0); } while (0)
        CMP_ISSUE(0); CMP_ISSUE(1); CMP_ISSUE(2);
#pragma unroll 1
        for (int st = 0; st < 32; ++st) {
            asm volatile("s_waitcnt vmcnt(10)" ::: "memory"); __builtin_amdgcn_s_barrier(); asm volatile("" ::: "memory");
            CMP_ISSUE(st + 3);
            const LAS unsigned char* sp = L + (st & 3) * CST_B;
            const bf16x8 af0 = *(const LAS bf16x8*)(sp + 32768 + (rg * 2) * 1024 + lane * 16), af1 = *(const LAS bf16x8*)(sp + 32768 + (rg * 2 + 1) * 1024 + lane * 16);
            const LAS unsigned char* sb = sp + (c4 * 8) * 1024 + lane * 16;
#pragma unroll
            for (int c = 0; c < 4; ++c) {
                const bf16x8 wf0 = *(const LAS bf16x8*)(sb + (c * 2) * 1024), wf1 = *(const LAS bf16x8*)(sb + (c * 2 + 1) * 1024);
                acc[c] = MFMA16(wf0, af0, acc[c]); acc[c] = MFMA16(wf1, af1, acc[c]);
            }
        }
        asm volatile("s_waitcnt vmcnt(0)" ::: "memory"); __builtin_amdgcn_s_barrier(); asm volatile("" ::: "memory");
#undef CMP_ISSUE
    }
    const float* b1p = (const float*)(ws + WS_B1P) + (l * 2 + kv) * 256 + 64 * c4;
    LAS u32x4* hx = (LAS u32x4*)L;
#pragma unroll
    for (int ss = 0; ss < 2; ++ss) {
        const f32x4 ba = *(const f32x4*)(b1p + 32 * ss + 4 * fq), bb = *(const f32x4*)(b1p + 32 * ss + 16 + 4 * fq);
        const f32x4 a = acc[2 * ss] + ba, c2 = acc[2 * ss + 1] + bb;
        u32x4 w; w.x = pk2(gelu_tanh(a.x), gelu_tanh(a.y)); w.y = pk2(gelu_tanh(a.z), gelu_tanh(a.w));
        w.z = pk2(gelu_tanh(c2.x), gelu_tanh(c2.y)); w.w = pk2(gelu_tanh(c2.z), gelu_tanh(c2.w));
        hx[(rg * 8 + 2 * c4 + ss) * 64 + lane] = w;
    }
    asm volatile("s_waitcnt lgkmcnt(0)" ::: "memory"); __builtin_amdgcn_s_barrier(); asm volatile("" ::: "memory");
    if (c4 == 0) {
        bf16x8 hf[8];
#pragma unroll
        for (int s2 = 0; s2 < 8; ++s2) hf[s2] = __builtin_bit_cast(bf16x8, hx[(rg * 8 + s2) * 64 + lane]);
        const bf16_t* w2t = (const bf16_t*)(ws + WS_W2T) + (size_t)(l * 2 + kv) * 64 * 256;
        f32x4 o[4];
#pragma unroll
        for (int ct = 0; ct < 4; ++ct) {
            o[ct] = (f32x4){0.f, 0.f, 0.f, 0.f};
            const bf16_t* wr = w2t + (size_t)(16 * ct + fr) * 256 + 4 * fq;
#pragma unroll
            for (int s2 = 0; s2 < 8; ++s2) {
                const u32x2 lo = *(const u32x2*)(wr + 32 * s2), hi = *(const u32x2*)(wr + 32 * s2 + 16);
                u32x4 w; w.x = lo.x; w.y = lo.y; w.z = hi.x; w.w = hi.y;
                o[ct] = MFMA16(__builtin_bit_cast(bf16x8, w), hf[s2], o[ct]);
            }
            o[ct] = o[ct] + *(const f32x4*)(p.b2 + (l * 2 + kv) * 64 + 16 * ct + 4 * fq);
        }
        const bool padrow = (i == 1023);
        if (kv == 0) {
            float ss = 0.f;
#pragma unroll
            for (int ct = 0; ct < 4; ++ct) { const f32x4 q = o[ct] * o[ct]; ss += (q.x + q.y) + (q.z + q.w); }
            ss = sx16(ss); ss = sx32(ss);
            const float rs = padrow ? 0.f : rsqrtf(ss * (1.0f / 64.0f) + EPS_);
            bf16_t* dst = (bf16_t*)(ws + WS_KCMP) + ((size_t)((b * 2 + g) * 1024 + i)) * 64 + 4 * fq;
            const float* gk0 = p.g_k + l * 192;
#pragma unroll
            for (int ct = 0; ct < 4; ++ct) {
                const f32x4 gg = *(const f32x4*)(gk0 + 16 * ct + 4 * fq); const f32x4 v = o[ct] * gg * rs;
                u32x2 w; w.x = pk2(v.x, v.y); w.y = pk2(v.z, v.w); *(u32x2*)(dst + 16 * ct) = w;
            }
        } else {
            bf16_t* dst = (bf16_t*)(ws + WS_VCMPT) + ((size_t)((b * 2 + g) * 64 + 4 * fq)) * 1024 + i;
            const float z = padrow ? 0.f : 1.f;
#pragma unroll
            for (int ct = 0; ct < 4; ++ct) {
                const f32x4 v = o[ct] * z; const unsigned w0 = pk2(v.x, v.y), w1 = pk2(v.z, v.w);
                dst[(size_t)(16 * ct + 0) * 1024] = (bf16_t)(w0 & 0xffff); dst[(size_t)(16 * ct + 1) * 1024] = (bf16_t)(w0 >> 16);
                dst[(size_t)(16 * ct + 2) * 1024] = (bf16_t)(w1 & 0xffff); dst[(size_t)(16 * ct + 3) * 1024] = (bf16_t)(w1 >> 16);
            }
        }
    }
    asm volatile("s_waitcnt lgkmcnt(0)" ::: "memory"); __builtin_amdgcn_s_barrier(); asm volatile("" ::: "memory");
}

constexpr int RING_ST = 5, PFD = 4;
constexpr int AL_PRIV = 81920, AL_PRIVSZ = 9728, AL_UW = 159744, AL_ULIST = 160000;
#define CST(i) ((float)(16 * ((i) >> 3) + ((i) & 7)))
struct VFrag { bf16x8 v0, v1, v2, v3; };
DI VFrag vload(const LAS unsigned char* st, int lane) {
    VFrag f; f.v0 = *(const LAS bf16x8*)(st + 4096 + lane * 16); f.v1 = *(const LAS bf16x8*)(st + 5120 + lane * 16); f.v2 = *(const LAS bf16x8*)(st + 6144 + lane * 16); f.v3 = *(const LAS bf16x8*)(st + 7168 + lane * 16);
    return f;
}
DI void pv32l(f32x16 (&o)[2], const VFrag& f, const float (&e)[16]) {
    u32x4 w0, w1;
    w0.x = pk2(e[0], e[1]); w0.y = pk2(e[2], e[3]); w0.z = pk2(e[4], e[5]); w0.w = pk2(e[6], e[7]);
    w1.x = pk2(e[8], e[9]); w1.y = pk2(e[10], e[11]); w1.z = pk2(e[12], e[13]); w1.w = pk2(e[14], e[15]);
    const bf16x8 p0 = __builtin_bit_cast(bf16x8, w0), p1 = __builtin_bit_cast(bf16x8, w1);
    o[0] = MFMA32(f.v0, p0, o[0]); o[1] = MFMA32(f.v2, p0, o[1]); o[0] = MFMA32(f.v1, p1, o[0]); o[1] = MFMA32(f.v3, p1, o[1]);
}
#define CST(i) ((float)(16 * ((i) >> 3) + ((i) & 7)))
template <int MODE> DI void tile_probs(float (&e)[16], const LAS unsigned char* st, const bf16x8 (&qf)[4], const int lane, const float slk, const float tb, const float basef, const bool sel) {
    f32x16 s;
#pragma unroll
    for (int i = 0; i < 16; ++i) s[i] = fmaf(slk, CST(i), tb);
    {
        bf16x8 k0 = *(const LAS bf16x8*)(st + lane * 16), k1 = *(const LAS bf16x8*)(st + 1024 + lane * 16), k2 = *(const LAS bf16x8*)(st + 2048 + lane * 16), k3 = *(const LAS bf16x8*)(st + 3072 + lane * 16);
        __builtin_amdgcn_sched_barrier(0);
        s = MFMA32(k0, qf[0], s); s = MFMA32(k1, qf[1], s); s = MFMA32(k2, qf[2], s); s = MFMA32(k3, qf[3], s);
    }
#pragma unroll
    for (int i = 0; i < 16; ++i) {
        float v = fexp2(s[i]);
        if (MODE == 1) { const float dist = basef - 16.0f * CST(i); v = dist >= 0.f ? v : 0.f; }
        if (MODE == 2) { const float dist = basef - CST(i); v = (dist >= 0.f && dist <= 511.f) ? v : 0.f; }
        if (MODE == 3) { const float dist = basef - CST(i); v = (sel && dist >= 0.f) ? v : 0.f; }
        e[i] = v;
    }
}
DI f32x16 qk_bias(const LAS unsigned char* st, const bf16x8 (&qf)[4], const int lane, const float slk, const float tb) {
    f32x16 s;
#pragma unroll
    for (int i = 0; i < 16; ++i) s[i] = fmaf(slk, CST(i), tb);
    {
        bf16x8 k0 = *(const LAS bf16x8*)(st + lane * 16), k1 = *(const LAS bf16x8*)(st + 1024 + lane * 16), k2 = *(const LAS bf16x8*)(st + 2048 + lane * 16), k3 = *(const LAS bf16x8*)(st + 3072 + lane * 16);
        __builtin_amdgcn_sched_barrier(0);
        s = MFMA32(k0, qf[0], s); s = MFMA32(k1, qf[1], s); s = MFMA32(k2, qf[2], s); s = MFMA32(k3, qf[3], s);
    }
    return s;
}
template <int MODE> DI void probs_from(float (&e)[16], const f32x16& s, const float basef, const bool sel) {
#pragma unroll
    for (int i = 0; i < 16; ++i) {
        float v = fexp2(s[i]);
        if (MODE == 1) { const float dist = basef - 16.0f * CST(i); v = dist >= 0.f ? v : 0.f; }
        if (MODE == 2) { const float dist = basef - CST(i); v = (dist >= 0.f && dist <= 511.f) ? v : 0.f; }
        if (MODE == 3) { const float dist = basef - CST(i); v = (sel && dist >= 0.f) ? v : 0.f; }
        e[i] = v;
    }
}
#define ATT_DMA2(g0_, g1_, n) do { LAS unsigned char* d_ = L + ((n) % RING_ST) * 16384 + wave * 1024; \
    __builtin_amdgcn_global_load_lds((const unsigned*)(g0_), (LAS unsigned*)d_, 16, 0, 0); __builtin_amdgcn_global_load_lds((const unsigned*)(g1_), (LAS unsigned*)(d_ + 8192), 16, 0, 0); } while (0)
#define ATT_STEP() do { asm volatile("s_waitcnt vmcnt(6)" ::: "memory"); __builtin_amdgcn_s_barrier(); asm volatile("" ::: "memory"); } while (0)
#define ATT_DRAIN() do { asm volatile("s_waitcnt vmcnt(0)" ::: "memory"); __builtin_amdgcn_s_barrier(); asm volatile("" ::: "memory"); } while (0)

DI void attn_wg_unit(const Params& p, const int l, const int b, const int TT, LAS unsigned char* L, const int wave, const int lane, const int gw) {
    unsigned char* ws = p.ws;
    const bf16_t* Q = (const bf16_t*)(ws + WS_Q); const bf16_t* KS = (const bf16_t*)(ws + WS_KS); const bf16_t* KW = (const bf16_t*)(ws + WS_KW);
    const bf16_t* VST = (const bf16_t*)(ws + WS_VST); const bf16_t* VWT = (const bf16_t*)(ws + WS_VWT);
    const bf16_t* KCMP = (const bf16_t*)(ws + WS_KCMP); const bf16_t* VCMPT = (const bf16_t*)(ws + WS_VCMPT);
    const float* GATE = (const float*)(ws + WS_GATE); bf16_t* MIXED = (bf16_t*)(ws + WS_MIXED);
    LAS unsigned char* wl = L + AL_PRIV + wave * AL_PRIVSZ;
    LAS float* imp = (LAS float*)wl;
    LAS float* pst = (LAS float*)(wl + 8192);
    LAS float* carry = (LAS float*)(wl + 8192 + 1152);
    LAS unsigned* selm = (LAS unsigned*)(wl + 8192 + 1152 + 64);
    LAS unsigned* selu = (LAS unsigned*)(wl + 8192 + 1152 + 64 + 256);
    LAS unsigned* seli = (LAS unsigned*)(wl + 8192 + 1152 + 64 + 256 + 32);
    LAS unsigned* uw = (LAS unsigned*)(L + AL_UW);
    LAS unsigned char* ulist = L + AL_ULIST;
    const int q = lane & 31, hi = lane >> 5, tok = q >> 2, hh = q & 3, T0 = TT * 64, t0 = T0 + wave * 8, t = t0 + tok;
    const size_t row = (size_t)b * T_ + t;
    const int m_ = lane & 31, kvp = (m_ & ~12) | ((m_ & 4) << 1) | ((m_ & 8) >> 1);
    float mref0, mref1, mref2, smax0;
    {
        const float gqm = wave_maxf(fabsf(p.g_q[l * 64 + lane]));
        smax0 = 8.0f * gqm * wave_maxf(fabsf(p.g_k[l * 192 + lane])) * LOG2E_;
        mref0 = fmaxf(0.f, smax0 - 100.0f);
        mref1 = fmaxf(0.f, 8.0f * gqm * wave_maxf(fabsf(p.g_k[l * 192 + 64 + lane])) * LOG2E_ - 100.0f);
        mref2 = fmaxf(0.f, 8.0f * gqm * wave_maxf(fabsf(p.g_k[l * 192 + 128 + lane])) * LOG2E_ - 100.0f);
    }
    const bool isK = wave < 4;
    const int kcol = (2 * wave + hi) * 8, vrow = 32 * ((wave - 4) >> 1) + (lane & 31), vcol = 16 * ((wave - 4) & 1) + 8 * hi;
    const int ekc = isK ? 64 : 1, ekw = isK ? 128 : 1;
    float* ogp = (float*)(ws + WS_OGP) + (size_t)gw * 12288;
    const int nt = ((((T0 + 63 - 31) >> 4) + 1) + 31) >> 5;
    const int kt0 = (T0 >= 511) ? ((T0 - 511) >> 5) : 0, nw = ((T0 + 63) >> 5) - kt0 + 1;
#pragma unroll 1
    for (int g = 0; g < 2; ++g) {
        float* ogg = ogp + g * 6144;
        const int head = g * 4 + hh; const float slope2 = __builtin_amdgcn_exp2f(-(float)(head + 1)) * LOG2E_;
        bf16x8 qf[4];
#pragma unroll
        for (int ks = 0; ks < 4; ++ks) qf[ks] = *(const bf16x8*)(Q + row * 512 + head * 64 + ks * 16 + hi * 8);
        const float gt0 = GATE[row * 24 + head * 3 + 0], gt1 = GATE[row * 24 + head * 3 + 1], gt2 = GATE[row * 24 + head * 3 + 2];
        const int bg2 = b * 2 + g;
        const bf16_t* bc = isK ? KCMP + ((size_t)(bg2 * 1024 + kvp) * 64 + kcol) : VCMPT + ((size_t)(bg2 * 64 + vrow) * 1024 + vcol);
        const bf16_t* bw = isK ? KW + (((size_t)b * T_ + kvp) * 128 + g * 64 + kcol) : VWT + ((size_t)(bg2 * 64 + vrow) * T_ + vcol);
        const bf16_t* bs = isK ? KS + (((size_t)b * T_ + kvp) * 128 + g * 64 + kcol) : VST + ((size_t)(bg2 * 64 + vrow) * T_ + vcol);
        int kts;
        {
            const float s2min = __builtin_amdgcn_exp2f(-(float)(4 * g + 4)) * LOG2E_;
            const float dcut = (smax0 * 1.02f + 130.0f - mref0) / s2min;
            const float y = ((float)T0 - dcut - 527.0f) * (1.0f / 512.0f);
            int k_ = y > 0.f ? (int)ceilf(y) : 0; k_ = k_ < nt - 1 ? k_ : nt - 1;
            kts = __builtin_amdgcn_readfirstlane(k_);
        }
        const int ntA = nt - kts;
        const int npA = (ntA + 1) >> 1;
#define ISSUE_A(n) do { const int n_ = (n); const int pc_ = n_ < npA ? n_ : (n_ < 2 * npA ? n_ - npA : 0); const int ka_ = kts + 2 * pc_, kb_ = ka_ + 1 < nt ? ka_ + 1 : nt - 1; \
            ATT_DMA2(bc + (size_t)(32 * ka_) * ekc, bc + (size_t)(32 * kb_) * ekc, n_); } while (0)
        for (int z = lane; z < 2048; z += 64) imp[z] = 0.f;
        if (lane < 8) carry[lane] = 0.f;
#pragma unroll 1
        for (int i = 0; i < PFD; ++i) ISSUE_A(i);
        float lsum = 0.f;
#pragma unroll 1
        for (int n = 0; n < npA; ++n) {
            ATT_STEP(); ISSUE_A(n + PFD);
#pragma unroll 1
          for (int h2 = 0; h2 < 2; ++h2) {
            const int kt1 = kts + 2 * n + h2; if (kt1 >= nt) break;
            const LAS unsigned char* st = L + (n % RING_ST) * 16384 + h2 * 8192;
            const int i0 = kt1 * 32;
            const float basef = (float)(t - 16 * i0 - 31 - 128 * hi), tb = fmaf(-slope2, basef, -mref0);
            float e[16];
            if (16 * (i0 + 31) + 31 <= t0) tile_probs<0>(e, st, qf, lane, 16.0f * slope2, tb, basef, true);
            else tile_probs<1>(e, st, qf, lane, 16.0f * slope2, tb, basef, true);
#pragma unroll
            for (int i = 0; i < 16; ++i) lsum += e[i];
          }
        }
        lsum = sx32(lsum);
        const float lgi = lsum > 0.f ? -__builtin_amdgcn_logf(lsum) : -1.0e30f;
        {
            f32x16 oc[2];
#pragma unroll
            for (int i = 0; i < 16; ++i) { oc[0][i] = 0.f; oc[1][i] = 0.f; }
            lds_fence();
#pragma unroll 1
            for (int n = npA; n < 2 * npA; ++n) {
                ATT_STEP(); ISSUE_A(n + PFD);
#pragma unroll 1
              for (int h2 = 0; h2 < 2; ++h2) {
                const int kt = kts + 2 * (n - npA) + h2; if (kt >= nt) break;
                const LAS unsigned char* st = L + (n % RING_ST) * 16384 + h2 * 8192;
                const int i0 = kt * 32;
                const float basef = (float)(t - 16 * i0 - 31 - 128 * hi), tb = fmaf(-slope2, basef, lgi - mref0);
                float e[16];
                const VFrag vf = vload(st, lane);
                if (16 * (i0 + 31) + 31 <= t0) tile_probs<0>(e, st, qf, lane, 16.0f * slope2, tb, basef, true);
                else tile_probs<1>(e, st, qf, lane, 16.0f * slope2, tb, basef, true);
                pv32l(oc, vf, e);
                float ps[16];
#pragma unroll
                for (int i = 0; i < 16; ++i) { ps[i] = sx2(sx1(e[i])); }
                if (hh == 0) {
                    LAS float* pr = pst + tok * 36 + 8 * hi;
                    *(LAS f32x4*)(pr) = (f32x4){ps[0], ps[1], ps[2], ps[3]}; *(LAS f32x4*)(pr + 4) = (f32x4){ps[4], ps[5], ps[6], ps[7]};
                    *(LAS f32x4*)(pr + 16) = (f32x4){ps[8], ps[9], ps[10], ps[11]}; *(LAS f32x4*)(pr + 20) = (f32x4){ps[12], ps[13], ps[14], ps[15]};
                }
                asm volatile("" ::: "memory");
                {
                    const int tk = lane >> 3, jj = lane & 7;
                    const f32x4 a = *(LAS f32x4*)(pst + tk * 36 + 4 * jj);
                    const float prev = (jj == 0) ? carry[tk] : pst[tk * 36 + 4 * jj - 1];
                    imp[tk * 256 + kt * 8 + jj] = (a.x + a.y) + a.z + 0.5f * (a.w + prev);
                    asm volatile("" ::: "memory");
                    if (jj == 7) carry[tk] = a.w;
                }
                asm volatile("" ::: "memory");
              }
            }
            if (nt < 32 && (lane & 7) == 0) imp[(lane >> 3) * 256 + nt * 8] = 0.5f * carry[lane >> 3];
            lds_fence();
            float* og_st = ogg + lane; asm volatile("" : "+v"(og_st));
#pragma unroll
            for (int dh = 0; dh < 2; ++dh)
#pragma unroll
                for (int i = 0; i < 16; ++i) og_st[(dh * 16 + i) * 64] = gt0 * oc[dh][i];
        }
        ATT_DRAIN();
        const int npW = nw >> 1;
        const int npre = npW < PFD ? npW : PFD;
#pragma unroll 1
        for (int i = 0; i < npre; ++i) ATT_DMA2(bw + (size_t)(32 * (kt0 + 2 * i)) * ekw, bw + (size_t)(32 * (kt0 + 2 * i + 1)) * ekw, i);
        {
            const int tk = lane >> 3, sub = lane & 7;
            const int jt = t0 >> 6;
            unsigned word;
            if (jt >= 16) {
                unsigned key[32];
#pragma unroll
                for (int k4 = 0; k4 < 8; ++k4) {
                    const f32x4 v = *(const LAS f32x4*)(imp + tk * 256 + 32 * sub + 4 * k4);
#pragma unroll
                    for (int c = 0; c < 4; ++c) {
                        const int j = 4 * k4 + c, J = 32 * sub + j;
                        const bool cand = J >= 1 && J <= jt - 2;
                        key[j] = cand ? ((__float_as_uint(v[c]) & 0xFFFFFF00u) | (unsigned)(255 - J)) : 0u;
                    }
                }
                unsigned prev = 0xFFFFFFFFu;
#pragma unroll 1
                for (int r = 0; r < 13; ++r) {
                    unsigned cur = 0u;
#pragma unroll
                    for (int j = 0; j < 32; ++j) { const unsigned c = key[j] < prev ? key[j] : 0u; cur = cur > c ? cur : c; }
                    unsigned w = DPPU(cur, 0xB1); cur = cur > w ? cur : w; w = DPPU(cur, 0x4E); cur = cur > w ? cur : w; w = DPPU(cur, 0x141); cur = cur > w ? cur : w;
                    prev = cur;
                }
                word = 0u;
#pragma unroll
                for (int j = 0; j < 32; ++j) word |= (key[j] != 0u && key[j] >= prev) ? (1u << j) : 0u;
                if (sub == 0) word |= 1u;
                if (sub == (jt >> 5)) word |= 1u << (jt & 31);
                if (sub == ((jt - 1) >> 5)) word |= 1u << ((jt - 1) & 31);
            } else {
                word = (sub == 0) ? ((2u << jt) - 1u) : 0u;
            }
            selm[tk * 8 + sub] = word;
            unsigned uo = word, ua = word;
            { const unsigned w = DPPU(uo, 0x128); uo |= w; const unsigned w2 = DPPU(ua, 0x128); ua &= w2; }
            { auto r = __builtin_amdgcn_permlane16_swap(uo, uo, false, false); uo = r[0] | r[1]; auto r2 = __builtin_amdgcn_permlane16_swap(ua, ua, false, false); ua = r2[0] & r2[1]; }
            { auto r = __builtin_amdgcn_permlane32_swap(uo, uo, false, false); uo = r[0] | r[1]; auto r2 = __builtin_amdgcn_permlane32_swap(ua, ua, false, false); ua = r2[0] & r2[1]; }
            if (lane < 8) { selu[lane] = uo; seli[lane] = ua; uw[wave * 8 + lane] = uo; }
        }
        asm volatile("s_waitcnt lgkmcnt(0)" ::: "memory"); __builtin_amdgcn_s_barrier(); asm volatile("" ::: "memory");
        int nu;
        {
            unsigned v = 0u;
            if (lane < 8) {
#pragma unroll
                for (int w2 = 0; w2 < 8; ++w2) v |= uw[w2 * 8 + lane];
            }
            unsigned U0 = (unsigned)__builtin_amdgcn_readlane((int)v, 0), U1 = (unsigned)__builtin_amdgcn_readlane((int)v, 1), U2 = (unsigned)__builtin_amdgcn_readlane((int)v, 2), U3 = (unsigned)__builtin_amdgcn_readlane((int)v, 3);
            unsigned U4 = (unsigned)__builtin_amdgcn_readlane((int)v, 4), U5 = (unsigned)__builtin_amdgcn_readlane((int)v, 5), U6 = (unsigned)__builtin_amdgcn_readlane((int)v, 6), U7 = (unsigned)__builtin_amdgcn_readlane((int)v, 7);
            const unsigned long long W0 = ((unsigned long long)U1 << 32) | U0, W1 = ((unsigned long long)U3 << 32) | U2, W2 = ((unsigned long long)U5 << 32) | U4, W3 = ((unsigned long long)U7 << 32) | U6;
            const int c0 = __builtin_popcountll(W0), c1 = __builtin_popcountll(W1), c2 = __builtin_popcountll(W2), c3 = __builtin_popcountll(W3);
            nu = c0 + c1 + c2 + c3;
            const unsigned long long below = (1ull << lane) - 1ull;
            if ((W0 >> lane) & 1ull) ulist[__builtin_popcountll(W0 & below)] = (unsigned char)lane;
            if ((W1 >> lane) & 1ull) ulist[c0 + __builtin_popcountll(W1 & below)] = (unsigned char)(64 + lane);
            if ((W2 >> lane) & 1ull) ulist[c0 + c1 + __builtin_popcountll(W2 & below)] = (unsigned char)(128 + lane);
            if ((W3 >> lane) & 1ull) ulist[c0 + c1 + c2 + __builtin_popcountll(W3 & below)] = (unsigned char)(192 + lane);
        }
        asm volatile("s_waitcnt lgkmcnt(0)" ::: "memory"); __builtin_amdgcn_s_barrier(); asm volatile("" ::: "memory");
        const int ntotB = npW + nu;
        const unsigned v_selu = lane < 8 ? selu[lane] : 0u, v_seli = lane < 8 ? seli[lane] : 0u;
        const int ul0 = ulist[lane], ul1 = ulist[64 + lane], ul2 = ulist[128 + lane], ul3 = ulist[192 + lane];
#define BLK_OF(idx) __builtin_amdgcn_readlane(((idx) < 64 ? ul0 : (idx) < 128 ? ul1 : (idx) < 192 ? ul2 : ul3), (idx) & 63)
#define MINE_OF(J) ((((unsigned)__builtin_amdgcn_readlane((int)v_selu, (J) >> 5)) >> ((J) & 31)) & 1u)
#define ALLS_OF(J) ((((unsigned)__builtin_amdgcn_readlane((int)v_seli, (J) >> 5)) >> ((J) & 31)) & 1u)
#define ISSUE_B(n) do { const int n_ = (n); const bf16_t* gp_; \
            if (n_ < npW || n_ >= ntotB) gp_ = bw + (size_t)(32 * (kt0 + (n_ < npW ? 2 * n_ : 0))) * ekw; \
            else { const int J_ = BLK_OF(n_ - npW); gp_ = bs + (size_t)(64 * J_) * ekw; } \
            ATT_DMA2(gp_, gp_ + (size_t)32 * ekw, n_); } while (0)
#pragma unroll 1
        for (int i = npre; i < PFD; ++i) ISSUE_B(i);
#define SLOT(n, h) (L + ((n) % RING_ST) * 16384 + (h) * 8192)
        {
            f32x16 o[2];
#pragma unroll
            for (int i = 0; i < 16; ++i) { o[0][i] = 0.f; o[1][i] = 0.f; }
            float ls = 0.f;
#pragma unroll 1
            for (int n = 0; n < npW; ++n) {
                ATT_STEP(); ISSUE_B(n + PFD);
#pragma unroll 1
              for (int h2 = 0; h2 < 2; ++h2) {
                const int kv0 = (kt0 + 2 * n + h2) * 32;
                if (kv0 + 31 >= t0 - 511 && kv0 <= t0 + 7) {
                    const float basef = (float)(t - kv0 - 8 * hi), tb = fmaf(-slope2, basef, -mref2);
                    float e[16];
                    const VFrag vf = vload(SLOT(n, h2), lane);
                    if (kv0 + 31 <= t0 && kv0 >= t0 + 7 - 511) tile_probs<0>(e, SLOT(n, h2), qf, lane, slope2, tb, basef, true);
                    else tile_probs<2>(e, SLOT(n, h2), qf, lane, slope2, tb, basef, true);
#pragma unroll
                    for (int i = 0; i < 16; ++i) ls += e[i];
                    pv32l(o, vf, e);
                }
              }
            }
            ls = sx32(ls);
            const float sc = gt2 * (ls > 0.f ? 1.0f / ls : 0.f);
            float* og_rw = ogg + 2048 + lane; asm volatile("" : "+v"(og_rw));
#pragma unroll
            for (int dh = 0; dh < 2; ++dh)
#pragma unroll
                for (int i = 0; i < 16; ++i) og_rw[(dh * 16 + i) * 64] = sc * o[dh][i];
        }
        {
            f32x16 o[2];
#pragma unroll
            for (int i = 0; i < 16; ++i) { o[0][i] = 0.f; o[1][i] = 0.f; }
            float ls = 0.f;
#pragma unroll 1
            for (int m2 = 0; m2 < nu; ++m2) {
                const int n = npW + m2;
                ATT_STEP(); ISSUE_B(n + PFD);
                const int J = BLK_OF(m2);
                const bool mine = MINE_OF(J), alls = ALLS_OF(J);
                if (mine) {
                  const bool sel = (selm[tok * 8 + (J >> 5)] >> (J & 31)) & 1u;
#pragma unroll 1
                  for (int h2 = 0; h2 < 2; ++h2) {
                    const int kv0 = 64 * J + 32 * h2;
                    if (kv0 <= t0 + 7) {
                        const float basef = (float)(t - kv0 - 8 * hi), tb = fmaf(-slope2, basef, -mref1);
                        float e[16];
                        const VFrag vf = vload(SLOT(n, h2), lane);
                        if (kv0 + 31 <= t0) tile_probs<0>(e, SLOT(n, h2), qf, lane, slope2, (alls || sel) ? tb : -1.0e30f, basef, true);
                        else tile_probs<3>(e, SLOT(n, h2), qf, lane, slope2, tb, basef, sel);
#pragma unroll
                        for (int i = 0; i < 16; ++i) ls += e[i];
                        pv32l(o, vf, e);
                    }
                  }
                }
            }
            ls = sx32(ls);
            const float sc = gt1 * (ls > 0.f ? 1.0f / ls : 0.f);
            float* og_rw = ogg + 4096 + lane; asm volatile("" : "+v"(og_rw));
#pragma unroll
            for (int dh = 0; dh < 2; ++dh)
#pragma unroll
                for (int i = 0; i < 16; ++i) og_rw[(dh * 16 + i) * 64] = sc * o[dh][i];
        }
#undef SLOT
#undef BLK_OF
#undef MINE_OF
#undef ALLS_OF
        ATT_DRAIN();
#undef ISSUE_A
#undef ISSUE_B
    }
    {
        int lt = lane; asm volatile("" : "+v"(lt));
        const int hi_t = lt >> 5, hh_t = lt & 3; const size_t row_t = (size_t)b * T_ + t0 + ((lt & 31) >> 2);
        f32x16 o0[2], og[2];
        const float* og_ld = ogp + lt;
#pragma unroll
        for (int dh = 0; dh < 2; ++dh)
#pragma unroll
            for (int i = 0; i < 16; ++i) { const int ix = (dh * 16 + i) * 64; o0[dh][i] = (og_ld[ix] + og_ld[2048 + ix]) + og_ld[4096 + ix]; og[dh][i] = (og_ld[6144 + ix] + og_ld[8192 + ix]) + og_ld[10240 + ix]; }
        float ss = 0.f;
#pragma unroll
        for (int dh = 0; dh < 2; ++dh)
#pragma unroll
            for (int i = 0; i < 16; ++i) ss += o0[dh][i] * o0[dh][i] + og[dh][i] * og[dh][i];
        ss = sx1(ss); ss = sx2(ss); ss = sx32(ss);
        const float rs = rsqrtf(ss * (1.0f / 512.0f) + EPS_);
#pragma unroll
        for (int dh = 0; dh < 2; ++dh)
#pragma unroll
            for (int i4 = 0; i4 < 4; ++i4) {
                u32x2 w; w.x = pk2(o0[dh][4 * i4] * rs, o0[dh][4 * i4 + 1] * rs); w.y = pk2(o0[dh][4 * i4 + 2] * rs, o0[dh][4 * i4 + 3] * rs);
                *(u32x2*)(MIXED + row_t * DM + hh_t * 64 + 32 * dh + 8 * i4 + 4 * hi_t) = w;
                u32x2 w1; w1.x = pk2(og[dh][4 * i4] * rs, og[dh][4 * i4 + 1] * rs); w1.y = pk2(og[dh][4 * i4 + 2] * rs, og[dh][4 * i4 + 3] * rs);
                *(u32x2*)(MIXED + row_t * DM + (4 + hh_t) * 64 + 32 * dh + 8 * i4 + 4 * hi_t) = w1;
            }
    }
    {
        const bf16_t* U = (const bf16_t*)(ws + WS_U); const bf16_t* BG = (const bf16_t*)(ws + WS_BG);
        int lc = lane; asm volatile("" : "+v"(lc));
        const float* cw = p.convw + l * 3 * 512 + 8 * lc;
        float w0[8], w1[8], w2[8];
#pragma unroll
        for (int j = 0; j < 8; ++j) { w0[j] = cw[j]; w1[j] = cw[512 + j]; w2[j] = cw[1024 + j]; }
        asm volatile("" ::: "memory");
        const u32x4 z4 = {0u, 0u, 0u, 0u};
#pragma unroll 1
        for (int half = 0; half < 2; ++half) {
            const int tb0 = t0 + 4 * half; const size_t r0 = (size_t)b * T_ + tb0;
            u32x4 uu[6], bgv[4];
            uu[0] = tb0 >= 2 ? *(const u32x4*)(U + (r0 - 2) * 512 + 8 * lc) : z4;
            uu[1] = tb0 >= 1 ? *(const u32x4*)(U + (r0 - 1) * 512 + 8 * lc) : z4;
#pragma unroll
            for (int tk = 0; tk < 4; ++tk) { uu[2 + tk] = *(const u32x4*)(U + (r0 + tk) * 512 + 8 * lc); bgv[tk] = *(const u32x4*)(BG + (r0 + tk) * 512 + 8 * lc); }
#pragma unroll
            for (int tk = 0; tk < 4; ++tk) {
                const size_t r = r0 + tk;
                const u32x4 u0 = uu[2 + tk], u1 = uu[1 + tk], u2 = uu[tk];
                float v[8]; float ss = 0.f;
#pragma unroll
                for (int j = 0; j < 4; ++j) {
                    v[2 * j] = bflo(bgv[tk][j]) * (w0[2 * j] * bflo(u2[j]) + w1[2 * j] * bflo(u1[j]) + w2[2 * j] * bflo(u0[j]));
                    v[2 * j + 1] = bfhi(bgv[tk][j]) * (w0[2 * j + 1] * bfhi(u2[j]) + w1[2 * j + 1] * bfhi(u1[j]) + w2[2 * j + 1] * bfhi(u0[j]));
                    ss += v[2 * j] * v[2 * j] + v[2 * j + 1] * v[2 * j + 1];
                }
                ss = wave_sum(ss);
                const float rs = rsqrtf(ss * (1.0f / 512.0f) + EPS_);
                u32x4 w; w.x = pk2(v[0] * rs, v[1] * rs); w.y = pk2(v[2] * rs, v[3] * rs); w.z = pk2(v[4] * rs, v[5] * rs); w.w = pk2(v[6] * rs, v[7] * rs);
                *(u32x4*)(MIXED + r * DM + 512 + 8 * lc) = w;
            }
        }
    }
}

#define RLX_AGENT __ATOMIC_RELAXED, __HIP_MEMORY_SCOPE_AGENT
#define XB_TMO      128
#define XB_XCNT(j)  (256  + 64 * (j))
#define XB_XSUB(j)  (1280 + 64 * (j))
#define XB_XGEN(j)  (2304 + 64 * (j))
#define XB_TOP      3328
#define XB_TOPGEN   3392
#define XCD_BAR_WORDS 3456
#define XB_SPIN_CAP (1u << 18)

__device__ __forceinline__ unsigned xb_ld(unsigned* p)              { return __hip_atomic_load(p, __ATOMIC_RELAXED, __HIP_MEMORY_SCOPE_AGENT); }
__device__ __forceinline__ unsigned xb_add(unsigned* p, unsigned v) { return __hip_atomic_fetch_add(p, v, __ATOMIC_RELAXED, __HIP_MEMORY_SCOPE_AGENT); }
__device__ __forceinline__ unsigned xb_xcc_id() { return (unsigned)__builtin_amdgcn_s_getreg((3 << 11) | 20) & 0xFu; }
#define XB_SPIN(cond, bar) do { unsigned _sp = 0; while (cond) { __builtin_amdgcn_s_sleep(1); \
    if ((++_sp & 255u) == 0u) { if (xb_ld(&(bar)[XB_TMO])) break; if (_sp > XB_SPIN_CAP) { atomicAdd(&(bar)[XB_TMO], 1u); break; } } } } while (0)

struct XcdBarrier {
    unsigned* bar; unsigned x; int wv;
    volatile LAS unsigned* st;
};

__device__ __forceinline__ XcdBarrier xcd_barrier_post(unsigned* bar, volatile LAS unsigned* st) {
    XcdBarrier b; b.bar = bar; b.x = xb_xcc_id(); b.st = st;
    if (threadIdx.x == 0) (void)xb_add(&bar[XB_XCNT(b.x)], 1u);
    return b;
}
__device__ __forceinline__ void xcd_barrier_complete(unsigned* bar, unsigned x, unsigned& nloc, unsigned& nx) {
    const unsigned G = gridDim.x * gridDim.y * gridDim.z;
    unsigned sum, cnt, mine, sp = 0u;
    for (;;) {
        sum = 0u; cnt = 0u; mine = 0u;
#pragma unroll
        for (unsigned j = 0; j < 16; ++j) { const unsigned c = xb_ld(&bar[XB_XCNT(j)]); sum += c; cnt += (c > 0u) ? 1u : 0u; mine = (j == x) ? c : mine; }
        if (sum == G) break;
        __builtin_amdgcn_s_sleep(1);
        if ((++sp & 255u) == 0u) { if (xb_ld(&bar[XB_TMO])) break; if (sp > XB_SPIN_CAP) { atomicAdd(&bar[XB_TMO], 1u); break; } }
    }
    nloc = mine > 0u ? mine : 1u; nx = cnt > 0u ? cnt : 1u;
}

__device__ __forceinline__ void xcd_barrier(const XcdBarrier& b) {
    asm volatile("s_waitcnt vmcnt(0)" ::: "memory");
    __syncthreads();
    if (b.wv == 0 && lane_mb() == 0) {
        unsigned* bar = b.bar; unsigned bx_ = b.x; asm volatile("" : "+s"(bar), "+s"(bx_));
        __builtin_amdgcn_s_waitcnt(0);
        unsigned nloc = b.st[0], nx = b.st[1];
        if (nloc == 0u) { xcd_barrier_complete(bar, bx_, nloc, nx); b.st[0] = nloc; b.st[1] = nx; }
        const unsigned old = xb_add(&bar[XB_XSUB(bx_)], 1u);
        const unsigned gen = old / nloc;
        if (old + 1u == (gen + 1u) * nloc) {
            __builtin_amdgcn_fence(__ATOMIC_RELEASE, "agent");
            asm volatile("s_waitcnt vmcnt(0)" ::: "memory");
            const unsigned og = xb_add(&bar[XB_TOP], 1u);
            const unsigned tg = og / nx;
            if (og + 1u == (tg + 1u) * nx) xb_add(&bar[XB_TOPGEN], 1u);
            else XB_SPIN(xb_ld(&bar[XB_TOPGEN]) == tg, bar);
            __builtin_amdgcn_fence(__ATOMIC_ACQUIRE, "agent");
            xb_add(&bar[XB_XGEN(bx_)], 1u);
            asm volatile("s_waitcnt vmcnt(0)" ::: "memory");
        } else {
            XB_SPIN(xb_ld(&bar[XB_XGEN(bx_)]) == gen, bar);
            __builtin_amdgcn_fence(__ATOMIC_ACQUIRE, "agent");
            asm volatile("s_waitcnt vmcnt(0)" ::: "memory");
        }
    }
    __syncthreads();
}

__global__ void __launch_bounds__(512, 2) nsa_trunk_fwd(Params p) {
    extern __shared__ __attribute__((aligned(16))) unsigned char lds[];
    cg::grid_group grid = cg::this_grid();
    LAS unsigned char* L = (LAS unsigned char*)lds;
    const int wave = __builtin_amdgcn_readfirstlane((int)(threadIdx.x >> 6));
#define TID_NOW() (wave * 64 + lane_mb())
#define LANE_NOW() (lane_mb())
    const int G = gridDim.x, gw = blockIdx.x * 8 + wave, ngw = G * 8;
    unsigned char* ws = p.ws;

    if (TID_NOW() == 0) { ((volatile LAS unsigned*)(L + AL_BARST))[0] = 0u; ((volatile LAS unsigned*)(L + AL_BARST))[1] = 0u; }
    __syncthreads();
    XcdBarrier bar = xcd_barrier_post((unsigned*)(ws + WS_BAR), (volatile LAS unsigned*)(L + AL_BARST)); bar.wv = wave;
    { int l0 = LANE_NOW(); asm volatile("" : "+v"(l0)); p0_prep(p, L, gw, ngw, wave, l0); }
    if (p.ws == nullptr) grid.sync();
    xcd_barrier(bar);
#pragma unroll 1
    for (int l = 0; l < DEPTH_; ++l) {
        if (l == 0 && blockIdx.x == 0) {
            const float* part = (const float*)(ws + WS_B1PART); float* b1p = (float*)(ws + WS_B1P);
            int tq = TID_NOW(); asm volatile("" : "+v"(tq));
            for (int o = tq; o < 8 * 256; o += 512) { const int lk = o >> 8, n = o & 255; float a = 0.f; for (int kc = 0; kc < 32; ++kc) a += part[(size_t)(lk * 32 + kc) * 256 + n]; b1p[o] = a; }
        }
        {
            pg8::Gemm g{(const bf16_t*)(ws + WS_XB), (const bf16_t*)(ws + WS_WIN) + (size_t)l * NIN * DM, M_, NIN, DM};
            pg8::StaticOrder S; S.init(M_, NIN, G, (int)blockIdx.x);
            EpiIn E{ws, p.g_q + l * 64, p.g_k + l * 192, 0.125f * LOG2E_};
            pg8::gemm_phase<EpiIn, pg8::StaticOrder, true, true>(L, g, S, E, wave);
        }
        xcd_barrier(bar);
        { int ln = LANE_NOW(); asm volatile("" : "+v"(ln));
#pragma unroll 1
          for (int u = blockIdx.x; u < 256; u += G) compress_wg_unit(p, l, u, L, wave, ln); }
        xcd_barrier(bar);
        {
            int ln = LANE_NOW(); asm volatile("" : "+v"(ln));
#pragma unroll 1
            for (int u = blockIdx.x; u < 512; u += G) { const int bb = u >= 256 ? 1 : 0, v_ = u & 255, t0_ = (G == 256) ? (v_ & 7) * 32 + (v_ >> 3) : v_, TT = bb ? 255 - t0_ : t0_;     int l2 = ln; asm volatile("" : "+v"(l2)); attn_wg_unit(p, l, bb, TT, L, wave, l2, gw); }
        }
        xcd_barrier(bar);
        {
            pg8::Gemm g{(const bf16_t*)(ws + WS_MIXED), (const bf16_t*)(ws + WS_WO) + (size_t)l * DM * DM, M_, DM, DM};
            pg8::StaticOrder S; S.init(M_, DM, G, (int)blockIdx.x);
            EpiRes E{l == 0 ? p.x : (const float*)p.out, p.out, (bf16_t*)(ws + WS_XB), (float*)(ws + WS_SSPB)};
            pg8::gemm_phase<EpiRes, pg8::StaticOrder, true, false>(L, g, S, E, wave);
        }
        xcd_barrier(bar);
#define FFN_UP(hf_) do { const size_t r0_ = (size_t)(hf_) * (M_ / 2); \
            pg8::Gemm g{(const bf16_t*)(ws + WS_XB) + r0_ * DM, (const bf16_t*)(ws + WS_WUP) + (size_t)l * DFF * DM, M_ / 2, DFF, DM}; \
            pg8::StaticOrder S; S.init(M_ / 2, DFF, G, (int)blockIdx.x); \
            EpiUp E{(const float*)(ws + WS_SSPB) + r0_ * 16, (bf16_t*)(ws + WS_H) + (size_t)(hf_) * (M_ / 2) * DFF}; \
            pg8::gemm_phase<EpiUp, pg8::StaticOrder, true, true>(L, g, S, E, wave); } while (0)
#define FFN_DOWN(hf_) do { const size_t r0_ = (size_t)(hf_) * (M_ / 2); \
            pg8::Gemm g{(const bf16_t*)(ws + WS_H) + (size_t)(hf_) * (M_ / 2) * DFF, (const bf16_t*)(ws + WS_WDN) + (size_t)l * DM * DFF, M_ / 2, DM, DFF}; \
            pg8::StaticOrder S; S.init(M_ / 2, DM, G, (int)blockIdx.x); \
            EpiRes E{(const float*)p.out + r0_ * DM, p.out + r0_ * DM, (bf16_t*)(ws + WS_XB) + r0_ * DM, (float*)(ws + WS_SSPA) + r0_ * 16}; \
            pg8::gemm_phase<EpiRes, pg8::StaticOrder, true, true>(L, g, S, E, wave); } while (0)
        FFN_UP(0);
        xcd_barrier(bar);
        FFN_DOWN(0);
        __syncthreads();
        FFN_UP(1);
        xcd_barrier(bar);
        FFN_DOWN(1);
#undef FFN_UP
#undef FFN_DOWN
        if (l + 1 < DEPTH_) xcd_barrier(bar);
    }
}

extern "C" void kernel_launch(void* const* d_in, const int* in_sizes, int n_in, void* d_out, int out_size, void* d_ws, size_t ws_size, hipStream_t stream) {
    static int grid = 0;
    if (grid == 0) {
        if (n_in != 16 || ws_size < WS_END) { fprintf(stderr, "kernel_launch: unexpected inputs (n_in %d, ws %zu)\n", n_in, ws_size); grid = -1; return; }
        int dev = 0, cus = 0, per_cu = 0;
        hipGetDevice(&dev); hipDeviceGetAttribute(&cus, hipDeviceAttributeMultiprocessorCount, dev);
        hipFuncSetAttribute((const void*)nsa_trunk_fwd, hipFuncAttributeMaxDynamicSharedMemorySize, LDS_BYTES);
        hipOccupancyMaxActiveBlocksPerMultiprocessor(&per_cu, (const void*)nsa_trunk_fwd, 512, LDS_BYTES);
        if (per_cu < 1) per_cu = 1;
        grid = cus * per_cu;
        (void)hipGetLastError();
    }
    if (grid < 0) return;
    Params p{};
    p.x = (const float*)d_in[0]; p.g_mix = (const float*)d_in[1]; p.w_in = (const float*)d_in[2]; p.g_q = (const float*)d_in[3]; p.g_k = (const float*)d_in[4];
    p.pe = (const float*)d_in[5]; p.w1 = (const float*)d_in[6]; p.b1 = (const float*)d_in[7]; p.w2 = (const float*)d_in[8]; p.b2 = (const float*)d_in[9];
    p.convw = (const float*)d_in[10]; p.g_out = (const float*)d_in[11]; p.w_o = (const float*)d_in[12]; p.g_ffn = (const float*)d_in[13]; p.w_up = (const float*)d_in[14]; p.w_dn = (const float*)d_in[15];
    p.out = (float*)d_out; p.ws = (unsigned char*)d_ws;
    if (hipMemsetAsync((unsigned char*)d_ws + WS_BAR, 0, 16384, stream) != hipSuccess) { fprintf(stderr, "kernel_launch: memset of the barrier words failed\n"); return; }
    void* args[] = {&p};
    hipError_t e = hipLaunchCooperativeKernel((const void*)nsa_trunk_fwd, dim3(grid), dim3(512), args, LDS_BYTES, stream);
    if (e != hipSuccess) fprintf(stderr, "cooperative launch failed: %s (grid %d)\n", hipGetErrorString(e), grid);
}
```

```cpp
#include <hip/hip_runtime.h>
#include <hip/hip_cooperative_groups.h>
#include <cstdio>
#include <cstdint>
namespace cg = cooperative_groups;
__device__ __forceinline__ int lane_mb() { unsigned z = 0u; asm volatile("" : "+v"(z)); return (int)__builtin_amdgcn_mbcnt_hi(~0u, __builtin_amdgcn_mbcnt_lo(~0u, z)); }
namespace pg8 {
#define PG8_LAS __attribute__((address_space(3)))
typedef unsigned short bf16_t;
typedef short bf16x8 __attribute__((ext_vector_type(8)));
typedef float f32x4 __attribute__((ext_vector_type(4)));
typedef unsigned u32x4 __attribute__((ext_vector_type(4)));
constexpr int BM = 256, BK = 64, HALF = 128, HTB = HALF * BK * 2  , STAGE_BYTES = 8 * HTB, NXCD = 8, WGM = 8;

__host__ __device__ __forceinline__ int lds_byte(int r, int c) { const int st = (r >> 4) * 2 + (c >> 5), rr = r & 15, cc = c & 31, ob = rr * 64 + cc * 2; return st * 1024 + (ob ^ (((ob >> 9) & 1) << 5)); }
__host__ __device__ __forceinline__ void stage_rc(int b, int& R, int& C) { const int st = b / 1024, sb = b % 1024, swz = sb ^ (((sb >> 9) & 1) << 5); R = (st >> 1) * 16 + swz / 64; C = (st & 1) * 32 + (swz % 64) / 2; }
__host__ __device__ __forceinline__ int perm32(int rho) { const int n = rho >> 4, i = rho & 15; return 8 * (i >> 2) + 4 * n + (i & 3); }

struct Unit { int pm, pn; };
struct Gemm { const bf16_t* A; const bf16_t* Bt; int M, N, K; };

struct StaticOrder {
    int nM, nN, nwg, G, c;
    __host__ __device__ void init(int M, int N, int G_, int c_) { nM = M / BM; nN = N / BM; nwg = nM * nN; G = G_; c = c_; }
    __host__ __device__ bool next(int i, Unit& u) const {
        const long L = (long)i * G + c; if (L >= nwg) return false;
        int wgid = (int)L; { const int q = nwg / NXCD, r = nwg % NXCD, xcd = wgid % NXCD, off = wgid / NXCD; wgid = (xcd < r ? xcd * (q + 1) : r * (q + 1) + (xcd - r) * q) + off; }
        const int nig = WGM * nN, gid = wgid / nig, fm = gid * WGM, gsz = (nM - fm) < WGM ? (nM - fm) : WGM;
        u.pm = fm + ((wgid % nig) % gsz); u.pn = (wgid % nig) / gsz; return true;
    }
    __device__ __forceinline__ void a_ready(const Unit&) const {}
    __device__ __forceinline__ void done(const Unit&) const {}
};
template <class Epi, class Sched, bool ALIGN_EPI = false, bool SP2 = false>
__device__ __forceinline__ void gemm_phase(PG8_LAS unsigned char* lds, const Gemm g, const Sched& S, const Epi& E, const int wave_in) {
    int tid_ = wave_in * 64 + lane_mb(); asm volatile("" : "+v"(tid_));
    const int tid = tid_, wid = __builtin_amdgcn_readfirstlane(tid >> 6), lane = tid & 63, wr = wid >> 2, wc = wid & 3, fr = lane & 15, fq = lane >> 4;
    const int K = g.K, nt = K / BK;
    unsigned voffA[2], voffB[2];
#pragma unroll
    for (int i = 0; i < 2; ++i) { int R, C; stage_rc(tid * 16 + i * 8192, R, C); const int Rb = Epi::PERM ? ((R & ~31) + perm32(R & 31)) : R;
        voffA[i] = (unsigned)(R * K + C) * 2u; voffB[i] = (unsigned)(Rb * K + C) * 2u; }
    const size_t kstep = (size_t)(BK * 2);
    const size_t hstep = (size_t)HALF * K * 2;
    const size_t tstep = 2 * hstep;
    const unsigned ldsw = (unsigned)wid * 1024u;
    const int aoff = lds_byte(wr * 64 + fr, fq * 8), boff = lds_byte(wc * 32 + fr, fq * 8);
#define PG8_SA(b, h) (((b) * 2 + (h)) * HTB)
#define PG8_SB(b, h) ((4 + (b) * 2 + (h)) * HTB)
#define PG8_STAGE(bufoff, gbase, voff) do { _Pragma("unroll") for (int _i = 0; _i < 2; ++_i) \
        __builtin_amdgcn_global_load_lds((const unsigned*)((const char*)(gbase) + (voff)[_i]), (PG8_LAS unsigned*)(lds + (bufoff) + ldsw + _i * 8192), 16, 0, 0); } while (0)
#define PG8_LDA(dst, b, h) do { _Pragma("unroll") for (int m = 0; m < 4; ++m) _Pragma("unroll") for (int k = 0; k < 2; ++k) dst[m][k] = *(const PG8_LAS bf16x8*)(lds + PG8_SA(b, h) + aoff + m * 2048 + k * 1024); } while (0)
#define PG8_LDB(dst, b, h) do { _Pragma("unroll") for (int n = 0; n < 2; ++n) _Pragma("unroll") for (int k = 0; k < 2; ++k) dst[n][k] = *(const PG8_LAS bf16x8*)(lds + PG8_SB(b, h) + boff + n * 2048 + k * 1024); } while (0)
#define PG8_MMA(ai, bj, At, Bt) do { __builtin_amdgcn_s_setprio(1); _Pragma("unroll") for (int m = 0; m < 4; ++m) _Pragma("unroll") for (int n = 0; n < 2; ++n) _Pragma("unroll") for (int k = 0; k < 2; ++k) \
        acc[ai][bj][m][n] = __builtin_amdgcn_mfma_f32_16x16x32_bf16(Bt[n][k], At[m][k], acc[ai][bj][m][n], 0, 0, 0); __builtin_amdgcn_s_setprio(0); } while (0)
#define PG8_WAIT_V(n) asm volatile("s_waitcnt vmcnt(" #n ")" ::: "memory")
#define PG8_WAIT_L(n) asm volatile("s_waitcnt lgkmcnt(" #n ")" ::: "memory")
#define PG8_BAR __builtin_amdgcn_s_barrier()
#define PG8_SCHED __builtin_amdgcn_sched_barrier(0)
    Unit cur, nxt; int ui = 0;
    if (!S.next(0, cur)) return;
    f32x4 acc[2][2][4][2];
#pragma unroll
    for (int a = 0; a < 2; ++a)
#pragma unroll
        for (int b = 0; b < 2; ++b)
#pragma unroll
            for (int m = 0; m < 4; ++m)
#pragma unroll
                for (int n = 0; n < 2; ++n) acc[a][b][m][n] = (f32x4){0.f, 0.f, 0.f, 0.f};
    bf16x8 At[4][2], B0[2][2], B1[2][2];
    const char* cA = (const char*)g.A + (size_t)cur.pm * tstep; const char* cB = (const char*)g.Bt + (size_t)cur.pn * tstep;
    S.a_ready(cur);
    if constexpr (SP2) {
        PG8_STAGE(PG8_SB(0, 0), cB, voffB); PG8_STAGE(PG8_SB(0, 1), cB + hstep, voffB); PG8_STAGE(PG8_SA(0, 0), cA, voffA); PG8_STAGE(PG8_SA(0, 1), cA + hstep, voffA);
        if (wr == 1) PG8_BAR;
        PG8_WAIT_V(2); PG8_BAR;
        PG8_STAGE(PG8_SB(1, 0), cB + kstep, voffB); PG8_STAGE(PG8_SA(1, 0), cA + kstep, voffA); PG8_STAGE(PG8_SB(1, 1), cB + hstep + kstep, voffB);
        PG8_WAIT_V(6); PG8_BAR;
    } else {
        PG8_STAGE(PG8_SB(0, 0), cB, voffB); PG8_STAGE(PG8_SA(0, 0), cA, voffA); PG8_STAGE(PG8_SB(0, 1), cB + hstep, voffB); PG8_STAGE(PG8_SA(0, 1), cA + hstep, voffA);
        if (wr == 1) PG8_BAR;
        PG8_WAIT_V(4); PG8_BAR;
        PG8_STAGE(PG8_SB(1, 0), cB + kstep, voffB); PG8_STAGE(PG8_SA(1, 0), cA + kstep, voffA); PG8_STAGE(PG8_SB(1, 1), cB + hstep + kstep, voffB);
        PG8_WAIT_V(6); PG8_BAR;
    }
    for (;;) {
        const bool has_next = S.next(ui + 1, nxt);
        const char* nA = has_next ? (const char*)g.A + (size_t)nxt.pm * tstep : cA; const char* nB = has_next ? (const char*)g.Bt + (size_t)nxt.pn * tstep : cB;
        for (int t = 0; t < nt; t += 2) {
            const bool last = (t == nt - 2);
            const char* a1 = cA + (size_t)(t + 1) * kstep;
            const char* a2 = last ? nA : cA + (size_t)(t + 2) * kstep; const char* b2 = last ? nB : cB + (size_t)(t + 2) * kstep;
            const char* a3 = a2 + kstep; const char* b3 = b2 + kstep;
            if (last && has_next) S.a_ready(nxt);
            if constexpr (SP2) {
            PG8_LDB(B0, 0, 0); PG8_LDB(B1, 0, 1); PG8_SCHED; PG8_LDA(At, 0, 0); PG8_STAGE(PG8_SA(1, 1), a1 + hstep, voffA);
            PG8_WAIT_V(8); PG8_WAIT_L(0); PG8_BAR; PG8_MMA(0, 0, At, B0); PG8_MMA(0, 1, At, B1); PG8_BAR; PG8_SCHED;
            PG8_LDA(At, 0, 1); PG8_STAGE(PG8_SB(0, 0), b2, voffB); PG8_STAGE(PG8_SB(0, 1), b2 + hstep, voffB); PG8_STAGE(PG8_SA(0, 0), a2, voffA);
            PG8_WAIT_V(8); PG8_WAIT_L(0); PG8_BAR; PG8_MMA(1, 0, At, B0); PG8_MMA(1, 1, At, B1); PG8_BAR; PG8_SCHED;
            PG8_LDB(B0, 1, 0); PG8_LDB(B1, 1, 1); PG8_SCHED; PG8_LDA(At, 1, 0); PG8_STAGE(PG8_SA(0, 1), a2 + hstep, voffA);
            PG8_WAIT_V(8); PG8_WAIT_L(0); PG8_BAR; PG8_MMA(0, 0, At, B0); PG8_MMA(0, 1, At, B1); PG8_BAR; PG8_SCHED;
            PG8_LDA(At, 1, 1); PG8_STAGE(PG8_SB(1, 0), b3, voffB); PG8_STAGE(PG8_SB(1, 1), b3 + hstep, voffB); PG8_STAGE(PG8_SA(1, 0), a3, voffA);
            PG8_WAIT_V(8); PG8_WAIT_L(0); PG8_BAR; PG8_MMA(1, 0, At, B0); PG8_MMA(1, 1, At, B1); PG8_BAR; PG8_SCHED;
            } else {
            PG8_LDB(B0, 0, 0); PG8_SCHED; PG8_LDA(At, 0, 0); PG8_STAGE(PG8_SA(1, 1), a1 + hstep, voffA);
            PG8_WAIT_L(8); PG8_BAR; PG8_WAIT_L(0); PG8_MMA(0, 0, At, B0); PG8_BAR; PG8_SCHED;
            PG8_LDB(B1, 0, 1); PG8_STAGE(PG8_SB(0, 0), b2, voffB);
            PG8_BAR; PG8_WAIT_L(0); PG8_MMA(0, 1, At, B1); PG8_BAR;
            PG8_LDA(At, 0, 1); PG8_STAGE(PG8_SA(0, 0), a2, voffA);
            PG8_BAR; PG8_WAIT_L(0); PG8_MMA(1, 0, At, B0); PG8_BAR; PG8_SCHED;
            PG8_STAGE(PG8_SB(0, 1), b2 + hstep, voffB);
            PG8_WAIT_V(6); PG8_BAR; PG8_MMA(1, 1, At, B1); PG8_BAR;
            PG8_LDB(B0, 1, 0); PG8_SCHED; PG8_LDA(At, 1, 0); PG8_STAGE(PG8_SA(0, 1), a2 + hstep, voffA);
            PG8_WAIT_L(8); PG8_BAR; PG8_WAIT_L(0); PG8_MMA(0, 0, At, B0); PG8_BAR; PG8_SCHED;
            PG8_LDB(B1, 1, 1); PG8_STAGE(PG8_SB(1, 0), b3, voffB);
            PG8_BAR; PG8_WAIT_L(0); PG8_MMA(0, 1, At, B1); PG8_BAR;
            PG8_LDA(At, 1, 1); PG8_STAGE(PG8_SA(1, 0), a3, voffA);
            PG8_BAR; PG8_WAIT_L(0); PG8_MMA(1, 0, At, B0); PG8_BAR; PG8_SCHED;
            PG8_STAGE(PG8_SB(1, 1), b3 + hstep, voffB);
            PG8_WAIT_V(6); PG8_BAR; PG8_MMA(1, 1, At, B1); PG8_BAR;
            }
        }
        if constexpr (ALIGN_EPI) { if (wr == 0) PG8_BAR; }
        if constexpr (!Epi::AFTER_DRAIN) { E(acc, cur, wr, wc, fr, fq); S.done(cur); }
        if (!has_next) break;
#pragma unroll
        for (int a = 0; a < 2; ++a)
#pragma unroll
            for (int b = 0; b < 2; ++b)
#pragma unroll
                for (int m = 0; m < 4; ++m)
#pragma unroll
                    for (int n = 0; n < 2; ++n) acc[a][b][m][n] = (f32x4){0.f, 0.f, 0.f, 0.f};
        cur = nxt; cA = nA; cB = nB; ++ui;
        if constexpr (ALIGN_EPI) { if (wr == 1) PG8_BAR; }
    }
    PG8_WAIT_V(0);
    if constexpr (!ALIGN_EPI) { if (wr == 0) PG8_BAR; }
    PG8_BAR;
    if constexpr (Epi::AFTER_DRAIN) { E.fused(acc, cur, wr, wc, fr, fq, lds, wid, lane); S.done(cur); }
#undef PG8_SA
#undef PG8_SB
#undef PG8_STAGE
#undef PG8_LDA
#undef PG8_LDB
#undef PG8_MMA
#undef PG8_WAIT_V
#undef PG8_WAIT_L
#undef PG8_BAR
#undef PG8_SCHED
}
}

#define DI __device__ __forceinline__
#define LAS __attribute__((address_space(3)))
typedef unsigned short bf16_t;
typedef short bf16x8 __attribute__((ext_vector_type(8)));
typedef float f32x4 __attribute__((ext_vector_type(4)));
typedef float f32x16 __attribute__((ext_vector_type(16)));
typedef unsigned u32x4 __attribute__((ext_vector_type(4)));
typedef unsigned u32x2 __attribute__((ext_vector_type(2)));
typedef float f32x2_t __attribute__((ext_vector_type(2)));
typedef __bf16 bf16x2_t __attribute__((ext_vector_type(2)));

constexpr int T_ = 16384, M_ = 32768, DM = 1024, NIN = 3072, DFF = 4096, DEPTH_ = 4;
constexpr float EPS_ = 1e-6f, LOG2E_ = 1.4426950408889634f;
constexpr size_t MiB = 1u << 20;
constexpr size_t WS_B1PART = 0, WS_B1P = 512 * 1024, WS_BAR = 1 * MiB  , WS_SSPA = 2 * MiB, WS_SSPB = 4 * MiB;
constexpr size_t WS_WIN = 8 * MiB, WS_WO = 32 * MiB, WS_WUP = 40 * MiB, WS_WDN = 72 * MiB, WS_W1T = 104 * MiB, WS_W2T = 112 * MiB;
constexpr size_t WS_KCMP = 114 * MiB, WS_VCMPT = 115 * MiB, WS_GATE = 116 * MiB, WS_XB = 120 * MiB, WS_H = 184 * MiB;
constexpr size_t WS_Q = 184 * MiB, WS_KC = 216 * MiB, WS_VC = 224 * MiB, WS_KS = 232 * MiB, WS_KW = 240 * MiB, WS_VST = 248 * MiB, WS_VWT = 256 * MiB,
                 WS_U = 264 * MiB, WS_BG = 296 * MiB, WS_MIXED = 328 * MiB, WS_OGP = 392 * MiB  , WS_END = 488 * MiB;
constexpr int LDS_BYTES = 163840, AL_BARST = 163776;

DI unsigned pk2(float lo, float hi) { f32x2_t v = {lo, hi}; bf16x2_t b = __builtin_convertvector(v, bf16x2_t); return __builtin_bit_cast(unsigned, b); }
DI float bflo(unsigned w) { return __uint_as_float(w << 16); }
DI float bfhi(unsigned w) { return __uint_as_float(w & 0xffff0000u); }
DI float fexp2(float x) { return __builtin_amdgcn_exp2f(x); }
DI float frcp(float x) { return __builtin_amdgcn_rcpf(x); }
#define MFMA32(a, b, c) __builtin_amdgcn_mfma_f32_32x32x16_bf16((a), (b), (c), 0, 0, 0)
#define MFMA16(a, b, c) __builtin_amdgcn_mfma_f32_16x16x32_bf16((a), (b), (c), 0, 0, 0)

DI float dpp_f(float v, const int ctrl) { return v; }
#define DPPF(v, ctrl) __builtin_bit_cast(float, __builtin_amdgcn_mov_dpp(__builtin_bit_cast(int, (float)(v)), (ctrl), 0xF, 0xF, true))
#define DPPU(v, ctrl) ((unsigned)__builtin_amdgcn_mov_dpp((int)(v), (ctrl), 0xF, 0xF, true))
DI float sx1(float v) { return v + DPPF(v, 0xB1); }
DI float sx2(float v) { return v + DPPF(v, 0x4E); }
DI float sx16(float v) { const unsigned u = __float_as_uint(v); auto r = __builtin_amdgcn_permlane16_swap(u, u, false, false); return __uint_as_float(r[0]) + __uint_as_float(r[1]); }
DI float sx32(float v) { const unsigned u = __float_as_uint(v); auto r = __builtin_amdgcn_permlane32_swap(u, u, false, false); return __uint_as_float(r[0]) + __uint_as_float(r[1]); }
DI void lds_fence() { asm volatile("s_waitcnt lgkmcnt(0)" ::: "memory"); __builtin_amdgcn_wave_barrier(); }

DI float row_rstd(const float* ssp, int row) {
    const f32x4* p = (const f32x4*)(ssp + (size_t)row * 16);
    const f32x4 a = p[0], b = p[1], c = p[2], d = p[3];
    const float s = ((a.x + a.y) + (a.z + a.w)) + ((b.x + b.y) + (b.z + b.w)) + ((c.x + c.y) + (c.z + c.w)) + ((d.x + d.y) + (d.z + d.w));
    return rsqrtf(s * (1.0f / 1024.0f) + EPS_);
}

DI void row_rstd8(float (&rs)[2][4], const float* ssp, const int rbase, const int fq) {
    f32x4 v[2][4];
#pragma unroll
    for (int ai = 0; ai < 2; ++ai)
#pragma unroll
        for (int m = 0; m < 4; ++m) v[ai][m] = *(const f32x4*)(ssp + (size_t)(rbase + ai * 128 + m * 16) * 16 + 4 * fq);
#pragma unroll
    for (int ai = 0; ai < 2; ++ai)
#pragma unroll
        for (int m = 0; m < 4; ++m) { float t = (v[ai][m].x + v[ai][m].y) + (v[ai][m].z + v[ai][m].w); t = sx16(t); t = sx32(t); rs[ai][m] = rsqrtf(t * (1.0f / 1024.0f) + EPS_); }
}

struct EpiIn {
    static constexpr bool PERM = true, AFTER_DRAIN = false;
    unsigned char* ws; const float *gq, *gk; float qscale;
    __device__ __forceinline__ void operator()(const f32x4 (&acc)[2][2][4][2], const pg8::Unit& u, int wr, int wc, int fr_, int fq_) const {
        int fr = fr_, fq = fq_; asm volatile("" : "+v"(fr), "+v"(fq));
        const float* ssp = (const float*)(ws + WS_SSPA);
        bf16_t* const Q = (bf16_t*)(ws + WS_Q); bf16_t* const KC = (bf16_t*)(ws + WS_KC); bf16_t* const VC = (bf16_t*)(ws + WS_VC); bf16_t* const KS = (bf16_t*)(ws + WS_KS); bf16_t* const KW = (bf16_t*)(ws + WS_KW);
        bf16_t* const VST = (bf16_t*)(ws + WS_VST); bf16_t* const VWT = (bf16_t*)(ws + WS_VWT); bf16_t* const U = (bf16_t*)(ws + WS_U); bf16_t* const BG = (bf16_t*)(ws + WS_BG); float* const GATE = (float*)(ws + WS_GATE);
        const int pn = u.pn;
        const int rbase = u.pm * 256 + wr * 64 + fr;
        float rs8[2][4]; row_rstd8(rs8, ssp, rbase, fq);
        if (pn < 2 || ((pn == 3 || pn == 4) && wc < 2)) {
            const float* g = (pn < 2) ? gq : gk + (pn == 3 ? 64 : 128);
            const float sc = (pn < 2) ? qscale : 1.0f;
            f32x4 gv[2][2];
#pragma unroll
            for (int bj = 0; bj < 2; ++bj)
#pragma unroll
                for (int n = 0; n < 2; ++n) gv[bj][n] = *(const f32x4*)(g + 32 * bj + 8 * fq + 4 * n);
            bf16_t* dst; int ld, cofs;
            if (pn < 2) { dst = Q; ld = 512; cofs = (pn * 4 + wc) * 64; } else { dst = (pn == 3) ? KS : KW; ld = 128; cofs = wc * 64; }
#pragma unroll
            for (int ai = 0; ai < 2; ++ai)
#pragma unroll
                for (int m = 0; m < 4; ++m) {
                    const int row = rbase + ai * 128 + m * 16; const float rs = rs8[ai][m];
                    f32x4 v[2][2]; float ss = 0.f;
#pragma unroll
                    for (int bj = 0; bj < 2; ++bj)
#pragma unroll
                        for (int n = 0; n < 2; ++n) { v[bj][n] = acc[ai][bj][m][n] * rs; const f32x4 q = v[bj][n] * v[bj][n]; ss += (q.x + q.y) + (q.z + q.w); }
                    ss = sx16(ss); ss = sx32(ss);
                    const float r2 = rsqrtf(ss * (1.0f / 64.0f) + EPS_) * sc;
#pragma unroll
                    for (int bj = 0; bj < 2; ++bj) {
                        const f32x4 a = v[bj][0] * gv[bj][0] * r2, b = v[bj][1] * gv[bj][1] * r2;
                        u32x4 w; w.x = pk2(a.x, a.y); w.y = pk2(a.z, a.w); w.z = pk2(b.x, b.y); w.w = pk2(b.z, b.w);
                        *(u32x4*)(dst + (size_t)row * ld + cofs + 32 * bj + 8 * fq) = w;
                    }
                }
        } else if (pn == 2) {
            bf16_t* dst = (wc < 2) ? KC : VC; const int cofs = (wc & 1) * 64;
#pragma unroll
            for (int ai = 0; ai < 2; ++ai)
#pragma unroll
                for (int m = 0; m < 4; ++m) {
                    const int row = rbase + ai * 128 + m * 16; const float rs = rs8[ai][m];
#pragma unroll
                    for (int bj = 0; bj < 2; ++bj) {
                        const f32x4 a = acc[ai][bj][m][0] * rs, b = acc[ai][bj][m][1] * rs;
                        u32x4 w; w.x = pk2(a.x, a.y); w.y = pk2(a.z, a.w); w.z = pk2(b.x, b.y); w.w = pk2(b.z, b.w);
                        *(u32x4*)(dst + (size_t)row * 128 + cofs + 32 * bj + 8 * fq) = w;
                    }
                }
        } else if (pn == 3 || pn == 4) {
            bf16_t* dst = (pn == 3) ? VST : VWT; const int g = wc & 1;
#pragma unroll
            for (int ai = 0; ai < 2; ++ai)
#pragma unroll
                for (int m = 0; m < 4; ++m) {
                    const int row = rbase + ai * 128 + m * 16; const float rs = rs8[ai][m];
                    const int b = row >> 14, t = row & (T_ - 1);
                    bf16_t* base = dst + (size_t)((b * 2 + g) * 64) * T_ + t;
#pragma unroll
                    for (int bj = 0; bj < 2; ++bj)
#pragma unroll
                        for (int n = 0; n < 2; ++n) {
                            const f32x4 a = acc[ai][bj][m][n] * rs; const int d0 = 32 * bj + 8 * fq + 4 * n;
                            const unsigned w0 = pk2(a.x, a.y), w1 = pk2(a.z, a.w);
                            base[(size_t)(d0 + 0) * T_] = (bf16_t)(w0 & 0xffff); base[(size_t)(d0 + 1) * T_] = (bf16_t)(w0 >> 16);
                            base[(size_t)(d0 + 2) * T_] = (bf16_t)(w1 & 0xffff); base[(size_t)(d0 + 3) * T_] = (bf16_t)(w1 >> 16);
                        }
                }
        } else if (pn < 9) {
            const int cofs = 128 * (pn - 5) + 32 * wc + 8 * fq;
#pragma unroll
            for (int ai = 0; ai < 2; ++ai)
#pragma unroll
                for (int m = 0; m < 4; ++m) {
                    const int row = rbase + ai * 128 + m * 16; const float rs = rs8[ai][m]; const float r2 = rs * rs;
                    const f32x4 a = acc[ai][0][m][0] * acc[ai][1][m][0] * r2, b = acc[ai][0][m][1] * acc[ai][1][m][1] * r2;
                    u32x4 w; w.x = pk2(a.x, a.y); w.y = pk2(a.z, a.w); w.z = pk2(b.x, b.y); w.w = pk2(b.z, b.w);
                    *(u32x4*)(U + (size_t)row * 512 + cofs) = w;
                }
        } else if (pn < 11) {
#pragma unroll
            for (int ai = 0; ai < 2; ++ai)
#pragma unroll
                for (int m = 0; m < 4; ++m) {
                    const int row = rbase + ai * 128 + m * 16; const float rs = rs8[ai][m];
#pragma unroll
                    for (int bj = 0; bj < 2; ++bj) {
                        const f32x4 a = acc[ai][bj][m][0] * rs, b = acc[ai][bj][m][1] * rs;
                        u32x4 w; w.x = pk2(a.x, a.y); w.y = pk2(a.z, a.w); w.z = pk2(b.x, b.y); w.w = pk2(b.z, b.w);
                        *(u32x4*)(BG + (size_t)row * 512 + 256 * (pn - 9) + 128 * bj + 32 * wc + 8 * fq) = w;
                    }
                }
        } else {
            if (wc == 0 && fq < 3) {
#pragma unroll
                for (int ai = 0; ai < 2; ++ai)
#pragma unroll
                    for (int m = 0; m < 4; ++m) {
                        const int row = rbase + ai * 128 + m * 16; const float rs = rs8[ai][m];
#pragma unroll
                        for (int n = 0; n < 2; ++n) {
                            const f32x4 a = acc[ai][0][m][n] * rs; f32x4 o;
                            o.x = frcp(1.0f + fexp2(-a.x * LOG2E_)); o.y = frcp(1.0f + fexp2(-a.y * LOG2E_));
                            o.z = frcp(1.0f + fexp2(-a.z * LOG2E_)); o.w = frcp(1.0f + fexp2(-a.w * LOG2E_));
                            *(f32x4*)(GATE + (size_t)row * 24 + 8 * fq + 4 * n) = o;
                        }
                    }
            }
        }
    }
};

struct EpiRes {
    static constexpr bool PERM = true, AFTER_DRAIN = false;
    const float* Xin; float* X; bf16_t* XB; float* ssp_out;
    __device__ __forceinline__ void operator()(const f32x4 (&acc)[2][2][4][2], const pg8::Unit& u, int wr, int wc, int fr_, int fq_) const {
        int fr = fr_, fq = fq_; asm volatile("" : "+v"(fr), "+v"(fq));
        const int rbase = u.pm * 256 + wr * 64 + fr, cbase = u.pn * 256 + wc * 32 + 8 * fq;
#pragma unroll
        for (int ai = 0; ai < 2; ++ai) {
            f32x4 xv[4][2][2];
#pragma unroll
            for (int m = 0; m < 4; ++m)
#pragma unroll
                for (int bj = 0; bj < 2; ++bj) { const float* xp = Xin + (size_t)(rbase + ai * 128 + m * 16) * DM + cbase + 128 * bj; xv[m][bj][0] = *(const f32x4*)xp; xv[m][bj][1] = *(const f32x4*)(xp + 4); }
#pragma unroll
            for (int m = 0; m < 4; ++m) {
                const int row = rbase + ai * 128 + m * 16; float ss = 0.f;
#pragma unroll
                for (int bj = 0; bj < 2; ++bj) {
                    float* xp = X + (size_t)row * DM + cbase + 128 * bj;
                    const f32x4 a = xv[m][bj][0] + acc[ai][bj][m][0], b = xv[m][bj][1] + acc[ai][bj][m][1];
                    __builtin_nontemporal_store(a, (f32x4*)xp); __builtin_nontemporal_store(b, (f32x4*)(xp + 4));
                    if (XB) {
                        u32x4 w; w.x = pk2(a.x, a.y); w.y = pk2(a.z, a.w); w.z = pk2(b.x, b.y); w.w = pk2(b.z, b.w);
                        *(u32x4*)(XB + (size_t)row * DM + cbase + 128 * bj) = w;
                        const f32x4 qa = a * a, qb = b * b; ss += ((qa.x + qa.y) + (qa.z + qa.w)) + ((qb.x + qb.y) + (qb.z + qb.w));
                    }
                }
                if (XB) {
                    ss = sx16(ss); ss = sx32(ss);
                    if (fq == 0) ssp_out[(size_t)row * 16 + u.pn * 4 + wc] = ss;
                }
            }
        }
    }
};

struct EpiUp {
    static constexpr bool PERM = true, AFTER_DRAIN = false;
    const float* ssp; bf16_t* H;
    __device__ __forceinline__ void operator()(const f32x4 (&acc)[2][2][4][2], const pg8::Unit& u, int wr, int wc, int fr_, int fq_) const {
        int fr = fr_, fq = fq_; asm volatile("" : "+v"(fr), "+v"(fq));
        const int rbase = u.pm * 256 + wr * 64 + fr, cbase = u.pn * 256 + wc * 32 + 8 * fq;
        float rs8[2][4]; row_rstd8(rs8, ssp, rbase, fq);
#pragma unroll
        for (int ai = 0; ai < 2; ++ai)
#pragma unroll
            for (int m = 0; m < 4; ++m) {
                const int row = rbase + ai * 128 + m * 16; const float rs = rs8[ai][m];
#pragma unroll
                for (int bj = 0; bj < 2; ++bj) {
                    f32x4 a = acc[ai][bj][m][0] * rs, b = acc[ai][bj][m][1] * rs;
                    a = __builtin_elementwise_max(a, (f32x4){0.f, 0.f, 0.f, 0.f}); b = __builtin_elementwise_max(b, (f32x4){0.f, 0.f, 0.f, 0.f});
                    a = a * a; b = b * b;
                    u32x4 w; w.x = pk2(a.x, a.y); w.y = pk2(a.z, a.w); w.z = pk2(b.x, b.y); w.w = pk2(b.z, b.w);
                    *(u32x4*)(H + (size_t)row * DFF + cbase + 128 * bj) = w;
                }
            }
    }
};

DI int win_src_col(int np) {
    const int tile = np >> 8, ct = np & 255, bj = ct >> 7, wc = (ct >> 5) & 3, w = ct & 31, d = 32 * bj + w;
    if (tile < 2) return (tile * 4 + wc) * 64 + d;
    if (tile < 5) return 512 + (tile - 2) * 256 + wc * 64 + d;
    if (tile < 9) return (bj ? 1816 : 1304) + 128 * (tile - 5) + (ct & 127);
    if (tile < 11) return 2328 + 256 * (tile - 9) + ct;
    return ct < 24 ? 1280 + ct : -1;
}
template <bool MAP> DI void tr_item(const float* W, int K, int N, bf16_t* WT, const float* gs, LAS float* scr, int kb, int nb, int lane) {
    const int k0 = 64 * kb, n0 = 32 * nb;
    const int np = n0 + (lane & 31); const int col = MAP ? win_src_col(np) : np;
    float tv[32];
#pragma unroll
    for (int i = 0; i < 32; ++i) { const int kk = 2 * i + (lane >> 5); tv[i] = (col >= 0) ? W[(size_t)(k0 + kk) * N + col] : 0.f; }
    if (gs) {
        const float g0 = gs[k0 + (lane >> 5) + 2 * (lane & 31)];
#pragma unroll
        for (int i = 0; i < 32; ++i) tv[i] *= __builtin_bit_cast(float, __builtin_amdgcn_ds_bpermute(4 * (i + (lane & 32)), __builtin_bit_cast(int, g0)));
    }
#pragma unroll
    for (int i = 0; i < 32; ++i) scr[(2 * i + (lane >> 5)) * 33 + (lane & 31)] = tv[i];
    lds_fence();
    const int c = lane & 7;
#pragma unroll
    for (int j = 0; j < 4; ++j) {
        const int n = (lane >> 3) + 8 * j; const LAS float* s = scr + (8 * c) * 33 + n;
        u32x4 o; o.x = pk2(s[0 * 33], s[1 * 33]); o.y = pk2(s[2 * 33], s[3 * 33]); o.z = pk2(s[4 * 33], s[5 * 33]); o.w = pk2(s[6 * 33], s[7 * 33]);
        *(u32x4*)(WT + (size_t)(n0 + n) * K + k0 + 8 * c) = o;
    }
    lds_fence();
}

struct Params {
    const float *x, *g_mix, *w_in, *g_q, *g_k, *pe, *w1, *b1, *w2, *b2, *convw, *g_out, *w_o, *g_ffn, *w_up, *w_dn;
    float* out; unsigned char* ws;
};

DI float wave_sum(float v) { v += DPPF(v, 0xB1); v += DPPF(v, 0x4E); v += DPPF(v, 0x141); v += DPPF(v, 0x140); v = sx16(v); return sx32(v); }
DI unsigned wave_maxu(unsigned v) {
    unsigned w = DPPU(v, 0xB1); v = v > w ? v : w; w = DPPU(v, 0x4E); v = v > w ? v : w; w = DPPU(v, 0x141); v = v > w ? v : w; w = DPPU(v, 0x140); v = v > w ? v : w;
    { auto r = __builtin_amdgcn_permlane16_swap(v, v, false, false); v = r[0] > r[1] ? r[0] : r[1]; }
    { auto r = __builtin_amdgcn_permlane32_swap(v, v, false, false); v = r[0] > r[1] ? r[0] : r[1]; }
    return v;
}
DI float wave_maxf(float v) {
    v = fmaxf(v, DPPF(v, 0xB1)); v = fmaxf(v, DPPF(v, 0x4E)); v = fmaxf(v, DPPF(v, 0x141)); v = fmaxf(v, DPPF(v, 0x140));
    { const unsigned u = __float_as_uint(v); auto r = __builtin_amdgcn_permlane16_swap(u, u, false, false); v = fmaxf(__uint_as_float(r[0]), __uint_as_float(r[1])); }
    { const unsigned u = __float_as_uint(v); auto r = __builtin_amdgcn_permlane32_swap(u, u, false, false); v = fmaxf(__uint_as_float(r[0]), __uint_as_float(r[1])); }
    return v;
}

DI void p0_prep(const Params& p, LAS unsigned char* lds, int gw, int ngw, int wave, int lane) {
    unsigned char* ws = p.ws;
    LAS float* scr = (LAS float*)(lds + wave * 8704);
    constexpr int I_WIN = 16 * 96, I_WO = 16 * 32, I_WUP = 16 * 128, I_WDN = 64 * 32, I_W1 = 32 * 8, I_W2 = 4 * 2;
    constexpr int PER_L = I_WIN + I_WO + I_WUP + I_WDN + 2 * I_W1 + 2 * I_W2;
    for (int it = gw; it < DEPTH_ * PER_L; it += ngw) {
        const int l = it / PER_L; int r = it % PER_L;
        if (r < I_WIN) { tr_item<true>(p.w_in + (size_t)l * DM * 2840, DM, 2840, (bf16_t*)(ws + WS_WIN) + (size_t)l * NIN * DM, p.g_mix + l * DM, scr, r / 96, r % 96, lane); continue; } r -= I_WIN;
        if (r < I_WO) { tr_item<false>(p.w_o + (size_t)l * DM * DM, DM, DM, (bf16_t*)(ws + WS_WO) + (size_t)l * DM * DM, p.g_out + l * DM, scr, r / 32, r % 32, lane); continue; } r -= I_WO;
        if (r < I_WUP) { tr_item<false>(p.w_up + (size_t)l * DM * DFF, DM, DFF, (bf16_t*)(ws + WS_WUP) + (size_t)l * DFF * DM, p.g_ffn + l * DM, scr, r / 128, r % 128, lane); continue; } r -= I_WUP;
        if (r < I_WDN) { tr_item<false>(p.w_dn + (size_t)l * DFF * DM, DFF, DM, (bf16_t*)(ws + WS_WDN) + (size_t)l * DM * DFF, nullptr, scr, r / 32, r % 32, lane); continue; } r -= I_WDN;
        if (r < 2 * I_W1) { const int kv = r / I_W1, q = r % I_W1; tr_item<false>(p.w1 + (size_t)(l * 2 + kv) * 2048 * 256, 2048, 256, (bf16_t*)(ws + WS_W1T) + (size_t)(l * 2 + kv) * 256 * 2048, nullptr, scr, q / 8, q % 8, lane); continue; } r -= 2 * I_W1;
        { const int kv = r / I_W2, q = r % I_W2; tr_item<false>(p.w2 + (size_t)(l * 2 + kv) * 256 * 64, 256, 64, (bf16_t*)(ws + WS_W2T) + (size_t)(l * 2 + kv) * 64 * 256, nullptr, scr, q / 2, q % 2, lane); }
    }
    bf16_t* XB = (bf16_t*)(ws + WS_XB); float* sspa = (float*)(ws + WS_SSPA);
    for (int m = gw; m < M_; m += ngw) {
        const f32x4* xr = (const f32x4*)(p.x + (size_t)m * DM) + lane;
        u32x2* xb = (u32x2*)(XB + (size_t)m * DM) + lane;
        f32x4 v[4];
#pragma unroll
        for (int j = 0; j < 4; ++j) v[j] = xr[64 * j];
        float s = 0.f;
#pragma unroll
        for (int j = 0; j < 4; ++j) { u32x2 w; w.x = pk2(v[j].x, v[j].y); w.y = pk2(v[j].z, v[j].w); xb[64 * j] = w; s += (v[j].x * v[j].x + v[j].y * v[j].y) + (v[j].z * v[j].z + v[j].w * v[j].w); }
        s = wave_sum(s);
        if (lane < 16) sspa[(size_t)m * 16 + lane] = (lane == 0) ? s : 0.f;
    }
    float* b1part = (float*)(ws + WS_B1PART);
    for (int it = blockIdx.x; it < 256; it += gridDim.x) {
        const int lk = it >> 5, kc = it & 31, tid = wave * 64 + lane;
        if (tid < 256) {
            const float* w = p.w1 + (size_t)lk * 2048 * 256 + (size_t)(kc * 64) * 256 + tid; const float* pe = p.pe + lk * 2048 + kc * 64;
            float a = (kc == 0) ? p.b1[lk * 256 + tid] : 0.f;
#pragma unroll 8
            for (int k = 0; k < 64; ++k) a += pe[k] * w[(size_t)k * 256];
            b1part[(size_t)it * 256 + tid] = a;
        }
    }
}

DI float gelu_tanh(float x) {
    const float u = 1.5957691216f * (x + 0.044715f * x * x * x);
    return x * frcp(1.0f + fexp2(-u * LOG2E_));
}
DI void compress_wg_unit(const Params& p, int l, int unit, LAS unsigned char* L, int wave, int lane) {
    unsigned char* ws = p.ws;
    const int rtp = unit & 31, g = (unit >> 5) & 1, b = (unit >> 6) & 1, kv = unit >> 7;
    const int rg = wave >> 2, c4 = wave & 3;
    const int fr = lane & 15, fq = lane >> 4, i0 = (rtp * 2 + rg) * 16, i = i0 + fr;
    f32x4 acc[4];
#pragma unroll
    for (int c = 0; c < 4; ++c) acc[c] = (f32x4){0.f, 0.f, 0.f, 0.f};
    {
        const bf16_t* w1base = (const bf16_t*)(ws + WS_W1T) + (size_t)(l * 2 + kv) * 256 * 2048;
        const bf16_t* gsrc[4];
#pragma unroll
        for (int q4 = 0; q4 < 4; ++q4) { const int blk = wave * 4 + q4, c4p = blk >> 3, cp = (blk >> 1) & 3, kkp = blk & 1; gsrc[q4] = w1base + (size_t)(64 * c4p + 16 * cp + fr) * 2048 + 32 * kkp + 8 * fq; }
        const int ab = wave & 3;
        const bf16_t* asrc = (const bf16_t*)(ws + (kv ? WS_VC : WS_KC)) + ((size_t)(b * T_ + 16 * ((rtp * 2 + (ab >> 1)) * 16 + fr)) * 128 + g * 64 + 8 * fq) + 32 * (ab & 1);
        constexpr int CST_B = 36864;
        const int rot = (blockIdx.x >> 3) & 31;
#define CMP_ISSUE(st_) do { const int s_ = (((st_) < 32 ? (st_) : 0) + rot) & 31; LAS unsigned char* sp_ = L + ((st_) & 3) * CST_B; _Pragma("unroll") for (int q4 = 0; q4 < 4; ++q4) \
            __builtin_amdgcn_global_load_lds((const unsigned*)(gsrc[q4] + 64 * s_), (LAS unsigned*)(sp_ + (wave * 4 + q4) * 1024), 16, 0, 0); \
            __builtin_amdgcn_global_load_lds((const unsigned*)(asrc + 128 * s_), (LAS unsigned*)(sp_ + 32768 + ab * 1024), 16, 0, 0); } while (0)
        CMP_ISSUE(0); CMP_ISSUE(1); CMP_ISSUE(2);
#pragma unroll 1
        for (int st = 0; st < 32; ++st) {
            asm volatile("s_waitcnt vmcnt(10)" ::: "memory"); __builtin_amdgcn_s_barrier(); asm volatile("" ::: "memory");
            CMP_ISSUE(st + 3);
            const LAS unsigned char* sp = L + (st & 3) * CST_B;
            const bf16x8 af0 = *(const LAS bf16x8*)(sp + 32768 + (rg * 2) * 1024 + lane * 16), af1 = *(const LAS bf16x8*)(sp + 32768 + (rg * 2 + 1) * 1024 + lane * 16);
            const LAS unsigned char* sb = sp + (c4 * 8) * 1024 + lane * 16;
#pragma unroll
            for (int c = 0; c < 4; ++c) {
                const bf16x8 wf0 = *(const LAS bf16x8*)(sb + (c * 2) * 1024), wf1 = *(const LAS bf16x8*)(sb + (c * 2 + 1) * 1024);
                acc[c] = MFMA16(wf0, af0, acc[c]); acc[c] = MFMA16(wf1, af1, acc[c]);
            }
        }
        asm volatile("s_waitcnt vmcnt(0)" ::: "memory"); __builtin_amdgcn_s_barrier(); asm volatile("" ::: "memory");
#undef CMP_ISSUE
    }
    const float* b1p = (const float*)(ws + WS_B1P) + (l * 2 + kv) * 256 + 64 * c4;
    LAS u32x4* hx = (LAS u32x4*)L;
#pragma unroll
    for (int ss = 0; ss < 2; ++ss) {
        const f32x4 ba = *(const f32x4*)(b1p + 32 * ss + 4 * fq), bb = *(const f32x4*)(b1p + 32 * ss + 16 + 4 * fq);
        const f32x4 a = acc[2 * ss] + ba, c2 = acc[2 * ss + 1] + bb;
        u32x4 w; w.x = pk2(gelu_tanh(a.x), gelu_tanh(a.y)); w.y = pk2(gelu_tanh(a.z), gelu_tanh(a.w));
        w.z = pk2(gelu_tanh(c2.x), gelu_tanh(c2.y)); w.w = pk2(gelu_tanh(c2.z), gelu_tanh(c2.w));
        hx[(rg * 8 + 2 * c4 + ss) * 64 + lane] = w;
    }
    asm volatile("s_waitcnt lgkmcnt(0)" ::: "memory"); __builtin_amdgcn_s_barrier(); asm volatile("" ::: "memory");
    if (c4 == 0) {
        bf16x8 hf[8];
#pragma unroll
        for (int s2 = 0; s2 < 8; ++s2) hf[s2] = __builtin_bit_cast(bf16x8, hx[(rg * 8 + s2) * 64 + lane]);
        const bf16_t* w2t = (const bf16_t*)(ws + WS_W2T) + (size_t)(l * 2 + kv) * 64 * 256;
        f32x4 o[4];
#pragma unroll
        for (int ct = 0; ct < 4; ++ct) {
            o[ct] = (f32x4){0.f, 0.f, 0.f, 0.f};
            const bf16_t* wr = w2t + (size_t)(16 * ct + fr) * 256 + 4 * fq;
#pragma unroll
            for (int s2 = 0; s2 < 8; ++s2) {
                const u32x2 lo = *(const u32x2*)(wr + 32 * s2), hi = *(const u32x2*)(wr + 32 * s2 + 16);
                u32x4 w; w.x = lo.x; w.y = lo.y; w.z = hi.x; w.w = hi.y;
                o[ct] = MFMA16(__builtin_bit_cast(bf16x8, w), hf[s2], o[ct]);
            }
            o[ct] = o[ct] + *(const f32x4*)(p.b2 + (l * 2 + kv) * 64 + 16 * ct + 4 * fq);
        }
        const bool padrow = (i == 1023);
        if (kv == 0) {
            float ss = 0.f;
#pragma unroll
            for (int ct = 0; ct < 4; ++ct) { const f32x4 q = o[ct] * o[ct]; ss += (q.x + q.y) + (q.z + q.w); }
            ss = sx16(ss); ss = sx32(ss);
            const float rs = padrow ? 0.f : rsqrtf(ss * (1.0f / 64.0f) + EPS_);
            bf16_t* dst = (bf16_t*)(ws + WS_KCMP) + ((size_t)((b * 2 + g) * 1024 + i)) * 64 + 4 * fq;
            const float* gk0 = p.g_k + l * 192;
#pragma unroll
            for (int ct = 0; ct < 4; ++ct) {
                const f32x4 gg = *(const f32x4*)(gk0 + 16 * ct + 4 * fq); const f32x4 v = o[ct] * gg * rs;
                u32x2 w; w.x = pk2(v.x, v.y); w.y = pk2(v.z, v.w); *(u32x2*)(dst + 16 * ct) = w;
            }
        } else {
            bf16_t* dst = (bf16_t*)(ws + WS_VCMPT) + ((size_t)((b * 2 + g) * 64 + 4 * fq)) * 1024 + i;
            const float z = padrow ? 0.f : 1.f;
#pragma unroll
            for (int ct = 0; ct < 4; ++ct) {
                const f32x4 v = o[ct] * z; const unsigned w0 = pk2(v.x, v.y), w1 = pk2(v.z, v.w);
                dst[(size_t)(16 * ct + 0) * 1024] = (bf16_t)(w0 & 0xffff); dst[(size_t)(16 * ct + 1) * 1024] = (bf16_t)(w0 >> 16);
                dst[(size_t)(16 * ct + 2) * 1024] = (bf16_t)(w1 & 0xffff); dst[(size_t)(16 * ct + 3) * 1024] = (bf16_t)(w1 >> 16);
            }
        }
    }
    asm volatile("s_waitcnt lgkmcnt(0)" ::: "memory"); __builtin_amdgcn_s_barrier(); asm volatile("" ::: "memory");
}

constexpr int RING_ST = 5, PFD = 4;
constexpr int AL_PRIV = 81920, AL_PRIVSZ = 9728, AL_UW = 159744, AL_ULIST = 160000;
#define CST(i) ((float)(16 * ((i) >> 3) + ((i) & 7)))
struct VFrag { bf16x8 v0, v1, v2, v3; };
DI VFrag vload(const LAS unsigned char* st, int lane) {
    VFrag f; f.v0 = *(const LAS bf16x8*)(st + 4096 + lane * 16); f.v1 = *(const LAS bf16x8*)(st + 5120 + lane * 16); f.v2 = *(const LAS bf16x8*)(st + 6144 + lane * 16); f.v3 = *(const LAS bf16x8*)(st + 7168 + lane * 16);
    return f;
}
DI void pv32l(f32x16 (&o)[2], const VFrag& f, const float (&e)[16]) {
    u32x4 w0, w1;
    w0.x = pk2(e[0], e[1]); w0.y = pk2(e[2], e[3]); w0.z = pk2(e[4], e[5]); w0.w = pk2(e[6], e[7]);
    w1.x = pk2(e[8], e[9]); w1.y = pk2(e[10], e[11]); w1.z = pk2(e[12], e[13]); w1.w = pk2(e[14], e[15]);
    const bf16x8 p0 = __builtin_bit_cast(bf16x8, w0), p1 = __builtin_bit_cast(bf16x8, w1);
    o[0] = MFMA32(f.v0, p0, o[0]); o[1] = MFMA32(f.v2, p0, o[1]); o[0] = MFMA32(f.v1, p1, o[0]); o[1] = MFMA32(f.v3, p1, o[1]);
}
#define CST(i) ((float)(16 * ((i) >> 3) + ((i) & 7)))
template <int MODE> DI void tile_probs(float (&e)[16], const LAS unsigned char* st, const bf16x8 (&qf)[4], const int lane, const float slk, const float tb, const float basef, const bool sel) {
    f32x16 s;
#pragma unroll
    for (int i = 0; i < 16; ++i) s[i] = fmaf(slk, CST(i), tb);
    {
        bf16x8 k0 = *(const LAS bf16x8*)(st + lane * 16), k1 = *(const LAS bf16x8*)(st + 1024 + lane * 16), k2 = *(const LAS bf16x8*)(st + 2048 + lane * 16), k3 = *(const LAS bf16x8*)(st + 3072 + lane * 16);
        __builtin_amdgcn_sched_barrier(0);
        s = MFMA32(k0, qf[0], s); s = MFMA32(k1, qf[1], s); s = MFMA32(k2, qf[2], s); s = MFMA32(k3, qf[3], s);
    }
#pragma unroll
    for (int i = 0; i < 16; ++i) {
        float v = fexp2(s[i]);
        if (MODE == 1) { const float dist = basef - 16.0f * CST(i); v = dist >= 0.f ? v : 0.f; }
        if (MODE == 2) { const float dist = basef - CST(i); v = (dist >= 0.f && dist <= 511.f) ? v : 0.f; }
        if (MODE == 3) { const float dist = basef - CST(i); v = (sel && dist >= 0.f) ? v : 0.f; }
        e[i] = v;
    }
}
DI f32x16 qk_bias(const LAS unsigned char* st, const bf16x8 (&qf)[4], const int lane, const float slk, const float tb) {
    f32x16 s;
#pragma unroll
    for (int i = 0; i < 16; ++i) s[i] = fmaf(slk, CST(i), tb);
    {
        bf16x8 k0 = *(const LAS bf16x8*)(st + lane * 16), k1 = *(const LAS bf16x8*)(st + 1024 + lane * 16), k2 = *(const LAS bf16x8*)(st + 2048 + lane * 16), k3 = *(const LAS bf16x8*)(st + 3072 + lane * 16);
        __builtin_amdgcn_sched_barrier(0);
        s = MFMA32(k0, qf[0], s); s = MFMA32(k1, qf[1], s); s = MFMA32(k2, qf[2], s); s = MFMA32(k3, qf[3], s);
    }
    return s;
}
template <int MODE> DI void probs_from(float (&e)[16], const f32x16& s, const float basef, const bool sel) {
#pragma unroll
    for (int i = 0; i < 16; ++i) {
        float v = fexp2(s[i]);
        if (MODE == 1) { const float dist = basef - 16.0f * CST(i); v = dist >= 0.f ? v : 0.f; }
        if (MODE == 2) { const float dist = basef - CST(i); v = (dist >= 0.f && dist <= 511.f) ? v : 0.f; }
        if (MODE == 3) { const float dist = basef - CST(i); v = (sel && dist >= 0.f) ? v : 0.f; }
        e[i] = v;
    }
}
#define ATT_DMA2(g0_, g1_, n) do { LAS unsigned char* d_ = L + ((n) % RING_ST) * 16384 + wave * 1024; \
    __builtin_amdgcn_global_load_lds((const unsigned*)(g0_), (LAS unsigned*)d_, 16, 0, 0); __builtin_amdgcn_global_load_lds((const unsigned*)(g1_), (LAS unsigned*)(d_ + 8192), 16, 0, 0); } while (0)
#define ATT_STEP() do { asm volatile("s_waitcnt vmcnt(6)" ::: "memory"); __builtin_amdgcn_s_barrier(); asm volatile("" ::: "memory"); } while (0)
#define ATT_DRAIN() do { asm volatile("s_waitcnt vmcnt(0)" ::: "memory"); __builtin_amdgcn_s_barrier(); asm volatile("" ::: "memory"); } while (0)

DI void attn_wg_unit(const Params& p, const int l, const int b, const int TT, LAS unsigned char* L, const int wave, const int lane, const int gw) {
    unsigned char* ws = p.ws;
    const bf16_t* Q = (const bf16_t*)(ws + WS_Q); const bf16_t* KS = (const bf16_t*)(ws + WS_KS); const bf16_t* KW = (const bf16_t*)(ws + WS_KW);
    const bf16_t* VST = (const bf16_t*)(ws + WS_VST); const bf16_t* VWT = (const bf16_t*)(ws + WS_VWT);
    const bf16_t* KCMP = (const bf16_t*)(ws + WS_KCMP); const bf16_t* VCMPT = (const bf16_t*)(ws + WS_VCMPT);
    const float* GATE = (const float*)(ws + WS_GATE); bf16_t* MIXED = (bf16_t*)(ws + WS_MIXED);
    LAS unsigned char* wl = L + AL_PRIV + wave * AL_PRIVSZ;
    LAS float* imp = (LAS float*)wl;
    LAS float* pst = (LAS float*)(wl + 8192);
    LAS float* carry = (LAS float*)(wl + 8192 + 1152);
    LAS unsigned* selm = (LAS unsigned*)(wl + 8192 + 1152 + 64);
    LAS unsigned* selu = (LAS unsigned*)(wl + 8192 + 1152 + 64 + 256);
    LAS unsigned* seli = (LAS unsigned*)(wl + 8192 + 1152 + 64 + 256 + 32);
    LAS unsigned* uw = (LAS unsigned*)(L + AL_UW);
    LAS unsigned char* ulist = L + AL_ULIST;
    const int q = lane & 31, hi = lane >> 5, tok = q >> 2, hh = q & 3, T0 = TT * 64, t0 = T0 + wave * 8, t = t0 + tok;
    const size_t row = (size_t)b * T_ + t;
    const int m_ = lane & 31, kvp = (m_ & ~12) | ((m_ & 4) << 1) | ((m_ & 8) >> 1);
    float mref0, mref1, mref2, smax0;
    {
        const float gqm = wave_maxf(fabsf(p.g_q[l * 64 + lane]));
        smax0 = 8.0f * gqm * wave_maxf(fabsf(p.g_k[l * 192 + lane])) * LOG2E_;
        mref0 = fmaxf(0.f, smax0 - 100.0f);
        mref1 = fmaxf(0.f, 8.0f * gqm * wave_maxf(fabsf(p.g_k[l * 192 + 64 + lane])) * LOG2E_ - 100.0f);
        mref2 = fmaxf(0.f, 8.0f * gqm * wave_maxf(fabsf(p.g_k[l * 192 + 128 + lane])) * LOG2E_ - 100.0f);
    }
    const bool isK = wave < 4;
    const int kcol = (2 * wave + hi) * 8, vrow = 32 * ((wave - 4) >> 1) + (lane & 31), vcol = 16 * ((wave - 4) & 1) + 8 * hi;
    const int ekc = isK ? 64 : 1, ekw = isK ? 128 : 1;
    float* ogp = (float*)(ws + WS_OGP) + (size_t)gw * 12288;
    const int nt = ((((T0 + 63 - 31) >> 4) + 1) + 31) >> 5;
    const int kt0 = (T0 >= 511) ? ((T0 - 511) >> 5) : 0, nw = ((T0 + 63) >> 5) - kt0 + 1;
#pragma unroll 1
    for (int g = 0; g < 2; ++g) {
        float* ogg = ogp + g * 6144;
        const int head = g * 4 + hh; const float slope2 = __builtin_amdgcn_exp2f(-(float)(head + 1)) * LOG2E_;
        bf16x8 qf[4];
#pragma unroll
        for (int ks = 0; ks < 4; ++ks) qf[ks] = *(const bf16x8*)(Q + row * 512 + head * 64 + ks * 16 + hi * 8);
        const float gt0 = GATE[row * 24 + head * 3 + 0], gt1 = GATE[row * 24 + head * 3 + 1], gt2 = GATE[row * 24 + head * 3 + 2];
        const int bg2 = b * 2 + g;
        const bf16_t* bc = isK ? KCMP + ((size_t)(bg2 * 1024 + kvp) * 64 + kcol) : VCMPT + ((size_t)(bg2 * 64 + vrow) * 1024 + vcol);
        const bf16_t* bw = isK ? KW + (((size_t)b * T_ + kvp) * 128 + g * 64 + kcol) : VWT + ((size_t)(bg2 * 64 + vrow) * T_ + vcol);
        const bf16_t* bs = isK ? KS + (((size_t)b * T_ + kvp) * 128 + g * 64 + kcol) : VST + ((size_t)(bg2 * 64 + vrow) * T_ + vcol);
        int kts;
        {
            const float s2min = __builtin_amdgcn_exp2f(-(float)(4 * g + 4)) * LOG2E_;
            const float dcut = (smax0 * 1.02f + 130.0f - mref0) / s2min;
            const float y = ((float)T0 - dcut - 527.0f) * (1.0f / 512.0f);
            int k_ = y > 0.f ? (int)ceilf(y) : 0; k_ = k_ < nt - 1 ? k_ : nt - 1;
            kts = __builtin_amdgcn_readfirstlane(k_);
        }
        const int ntA = nt - kts;
        const int npA = (ntA + 1) >> 1;
#define ISSUE_A(n) do { const int n_ = (n); const int pc_ = n_ < npA ? n_ : (n_ < 2 * npA ? n_ - npA : 0); const int ka_ = kts + 2 * pc_, kb_ = ka_ + 1 < nt ? ka_ + 1 : nt - 1; \
            ATT_DMA2(bc + (size_t)(32 * ka_) * ekc, bc + (size_t)(32 * kb_) * ekc, n_); } while (0)
        for (int z = lane; z < 2048; z += 64) imp[z] = 0.f;
        if (lane < 8) carry[lane] = 0.f;
#pragma unroll 1
        for (int i = 0; i < PFD; ++i) ISSUE_A(i);
        float lsum = 0.f;
#pragma unroll 1
        for (int n = 0; n < npA; ++n) {
            ATT_STEP(); ISSUE_A(n + PFD);
#pragma unroll 1
          for (int h2 = 0; h2 < 2; ++h2) {
            const int kt1 = kts + 2 * n + h2; if (kt1 >= nt) break;
            const LAS unsigned char* st = L + (n % RING_ST) * 16384 + h2 * 8192;
            const int i0 = kt1 * 32;
            const float basef = (float)(t - 16 * i0 - 31 - 128 * hi), tb = fmaf(-slope2, basef, -mref0);
            float e[16];
            if (16 * (i0 + 31) + 31 <= t0) tile_probs<0>(e, st, qf, lane, 16.0f * slope2, tb, basef, true);
            else tile_probs<1>(e, st, qf, lane, 16.0f * slope2, tb, basef, true);
#pragma unroll
            for (int i = 0; i < 16; ++i) lsum += e[i];
          }
        }
        lsum = sx32(lsum);
        const float lgi = lsum > 0.f ? -__builtin_amdgcn_logf(lsum) : -1.0e30f;
        {
            f32x16 oc[2];
#pragma unroll
            for (int i = 0; i < 16; ++i) { oc[0][i] = 0.f; oc[1][i] = 0.f; }
            lds_fence();
#pragma unroll 1
            for (int n = npA; n < 2 * npA; ++n) {
                ATT_STEP(); ISSUE_A(n + PFD);
#pragma unroll 1
              for (int h2 = 0; h2 < 2; ++h2) {
                const int kt = kts + 2 * (n - npA) + h2; if (kt >= nt) break;
                const LAS unsigned char* st = L + (n % RING_ST) * 16384 + h2 * 8192;
                const int i0 = kt * 32;
                const float basef = (float)(t - 16 * i0 - 31 - 128 * hi), tb = fmaf(-slope2, basef, lgi - mref0);
                float e[16];
                const VFrag vf = vload(st, lane);
                if (16 * (i0 + 31) + 31 <= t0) tile_probs<0>(e, st, qf, lane, 16.0f * slope2, tb, basef, true);
                else tile_probs<1>(e, st, qf, lane, 16.0f * slope2, tb, basef, true);
                pv32l(oc, vf, e);
                float ps[16];
#pragma unroll
                for (int i = 0; i < 16; ++i) { ps[i] = sx2(sx1(e[i])); }
                if (hh == 0) {
                    LAS float* pr = pst + tok * 36 + 8 * hi;
                    *(LAS f32x4*)(pr) = (f32x4){ps[0], ps[1], ps[2], ps[3]}; *(LAS f32x4*)(pr + 4) = (f32x4){ps[4], ps[5], ps[6], ps[7]};
                    *(LAS f32x4*)(pr + 16) = (f32x4){ps[8], ps[9], ps[10], ps[11]}; *(LAS f32x4*)(pr + 20) = (f32x4){ps[12], ps[13], ps[14], ps[15]};
                }
                asm volatile("" ::: "memory");
                {
                    const int tk = lane >> 3, jj = lane & 7;
                    const f32x4 a = *(LAS f32x4*)(pst + tk * 36 + 4 * jj);
                    const float prev = (jj == 0) ? carry[tk] : pst[tk * 36 + 4 * jj - 1];
                    imp[tk * 256 + kt * 8 + jj] = (a.x + a.y) + a.z + 0.5f * (a.w + prev);
                    asm volatile("" ::: "memory");
                    if (jj == 7) carry[tk] = a.w;
                }
                asm volatile("" ::: "memory");
              }
            }
            if (nt < 32 && (lane & 7) == 0) imp[(lane >> 3) * 256 + nt * 8] = 0.5f * carry[lane >> 3];
            lds_fence();
            float* og_st = ogg + lane; asm volatile("" : "+v"(og_st));
#pragma unroll
            for (int dh = 0; dh < 2; ++dh)
#pragma unroll
                for (int i = 0; i < 16; ++i) og_st[(dh * 16 + i) * 64] = gt0 * oc[dh][i];
        }
        ATT_DRAIN();
        const int npW = nw >> 1;
        const int npre = npW < PFD ? npW : PFD;
#pragma unroll 1
        for (int i = 0; i < npre; ++i) ATT_DMA2(bw + (size_t)(32 * (kt0 + 2 * i)) * ekw, bw + (size_t)(32 * (kt0 + 2 * i + 1)) * ekw, i);
        {
            const int tk = lane >> 3, sub = lane & 7;
            const int jt = t0 >> 6;
            unsigned word;
            if (jt >= 16) {
                unsigned key[32];
#pragma unroll
                for (int k4 = 0; k4 < 8; ++k4) {
                    const f32x4 v = *(const LAS f32x4*)(imp + tk * 256 + 32 * sub + 4 * k4);
#pragma unroll
                    for (int c = 0; c < 4; ++c) {
                        const int j = 4 * k4 + c, J = 32 * sub + j;
                        const bool cand = J >= 1 && J <= jt - 2;
                        key[j] = cand ? ((__float_as_uint(v[c]) & 0xFFFFFF00u) | (unsigned)(255 - J)) : 0u;
                    }
                }
                unsigned prev = 0xFFFFFFFFu;
#pragma unroll 1
                for (int r = 0; r < 13; ++r) {
                    unsigned cur = 0u;
#pragma unroll
                    for (int j = 0; j < 32; ++j) { const unsigned c = key[j] < prev ? key[j] : 0u; cur = cur > c ? cur : c; }
                    unsigned w = DPPU(cur, 0xB1); cur = cur > w ? cur : w; w = DPPU(cur, 0x4E); cur = cur > w ? cur : w; w = DPPU(cur, 0x141); cur = cur > w ? cur : w;
                    prev = cur;
                }
                word = 0u;
#pragma unroll
                for (int j = 0; j < 32; ++j) word |= (key[j] != 0u && key[j] >= prev) ? (1u << j) : 0u;
                if (sub == 0) word |= 1u;
                if (sub == (jt >> 5)) word |= 1u << (jt & 31);
                if (sub == ((jt - 1) >> 5)) word |= 1u << ((jt - 1) & 31);
            } else {
                word = (sub == 0) ? ((2u << jt) - 1u) : 0u;
            }
            selm[tk * 8 + sub] = word;
            unsigned uo = word, ua = word;
            { const unsigned w = DPPU(uo, 0x128); uo |= w; const unsigned w2 = DPPU(ua, 0x128); ua &= w2; }
            { auto r = __builtin_amdgcn_permlane16_swap(uo, uo, false, false); uo = r[0] | r[1]; auto r2 = __builtin_amdgcn_permlane16_swap(ua, ua, false, false); ua = r2[0] & r2[1]; }
            { auto r = __builtin_amdgcn_permlane32_swap(uo, uo, false, false); uo = r[0] | r[1]; auto r2 = __builtin_amdgcn_permlane32_swap(ua, ua, false, false); ua = r2[0] & r2[1]; }
            if (lane < 8) { selu[lane] = uo; seli[lane] = ua; uw[wave * 8 + lane] = uo; }
        }
        asm volatile("s_waitcnt lgkmcnt(0)" ::: "memory"); __builtin_amdgcn_s_barrier(); asm volatile("" ::: "memory");
        int nu;
        {
            unsigned v = 0u;
            if (lane < 8) {
#pragma unroll
                for (int w2 = 0; w2 < 8; ++w2) v |= uw[w2 * 8 + lane];
            }
            unsigned U0 = (unsigned)__builtin_amdgcn_readlane((int)v, 0), U1 = (unsigned)__builtin_amdgcn_readlane((int)v, 1), U2 = (unsigned)__builtin_amdgcn_readlane((int)v, 2), U3 = (unsigned)__builtin_amdgcn_readlane((int)v, 3);
            unsigned U4 = (unsigned)__builtin_amdgcn_readlane((int)v, 4), U5 = (unsigned)__builtin_amdgcn_readlane((int)v, 5), U6 = (unsigned)__builtin_amdgcn_readlane((int)v, 6), U7 = (unsigned)__builtin_amdgcn_readlane((int)v, 7);
            const unsigned long long W0 = ((unsigned long long)U1 << 32) | U0, W1 = ((unsigned long long)U3 << 32) | U2, W2 = ((unsigned long long)U5 << 32) | U4, W3 = ((unsigned long long)U7 << 32) | U6;
            const int c0 = __builtin_popcountll(W0), c1 = __builtin_popcountll(W1), c2 = __builtin_popcountll(W2), c3 = __builtin_popcountll(W3);
            nu = c0 + c1 + c2 + c3;
            const unsigned long long below = (1ull << lane) - 1ull;
            if ((W0 >> lane) & 1ull) ulist[__builtin_popcountll(W0 & below)] = (unsigned char)lane;
            if ((W1 >> lane) & 1ull) ulist[c0 + __builtin_popcountll(W1 & below)] = (unsigned char)(64 + lane);
            if ((W2 >> lane) & 1ull) ulist[c0 + c1 + __builtin_popcountll(W2 & below)] = (unsigned char)(128 + lane);
            if ((W3 >> lane) & 1ull) ulist[c0 + c1 + c2 + __builtin_popcountll(W3 & below)] = (unsigned char)(192 + lane);
        }
        asm volatile("s_waitcnt lgkmcnt(0)" ::: "memory"); __builtin_amdgcn_s_barrier(); asm volatile("" ::: "memory");
        const int ntotB = npW + nu;
        const unsigned v_selu = lane < 8 ? selu[lane] : 0u, v_seli = lane < 8 ? seli[lane] : 0u;
        const int ul0 = ulist[lane], ul1 = ulist[64 + lane], ul2 = ulist[128 + lane], ul3 = ulist[192 + lane];
#define BLK_OF(idx) __builtin_amdgcn_readlane(((idx) < 64 ? ul0 : (idx) < 128 ? ul1 : (idx) < 192 ? ul2 : ul3), (idx) & 63)
#define MINE_OF(J) ((((unsigned)__builtin_amdgcn_readlane((int)v_selu, (J) >> 5)) >> ((J) & 31)) & 1u)
#define ALLS_OF(J) ((((unsigned)__builtin_amdgcn_readlane((int)v_seli, (J) >> 5)) >> ((J) & 31)) & 1u)
#define ISSUE_B(n) do { const int n_ = (n); const bf16_t* gp_; \
            if (n_ < npW || n_ >= ntotB) gp_ = bw + (size_t)(32 * (kt0 + (n_ < npW ? 2 * n_ : 0))) * ekw; \
            else { const int J_ = BLK_OF(n_ - npW); gp_ = bs + (size_t)(64 * J_) * ekw; } \
            ATT_DMA2(gp_, gp_ + (size_t)32 * ekw, n_); } while (0)
#pragma unroll 1
        for (int i = npre; i < PFD; ++i) ISSUE_B(i);
#define SLOT(n, h) (L + ((n) % RING_ST) * 16384 + (h) * 8192)
        {
            f32x16 o[2];
#pragma unroll
            for (int i = 0; i < 16; ++i) { o[0][i] = 0.f; o[1][i] = 0.f; }
            float ls = 0.f;
#pragma unroll 1
            for (int n = 0; n < npW; ++n) {
                ATT_STEP(); ISSUE_B(n + PFD);
#pragma unroll 1
              for (int h2 = 0; h2 < 2; ++h2) {
                const int kv0 = (kt0 + 2 * n + h2) * 32;
                if (kv0 + 31 >= t0 - 511 && kv0 <= t0 + 7) {
                    const float basef = (float)(t - kv0 - 8 * hi), tb = fmaf(-slope2, basef, -mref2);
                    float e[16];
                    const VFrag vf = vload(SLOT(n, h2), lane);
                    if (kv0 + 31 <= t0 && kv0 >= t0 + 7 - 511) tile_probs<0>(e, SLOT(n, h2), qf, lane, slope2, tb, basef, true);
                    else tile_probs<2>(e, SLOT(n, h2), qf, lane, slope2, tb, basef, true);
#pragma unroll
                    for (int i = 0; i < 16; ++i) ls += e[i];
                    pv32l(o, vf, e);
                }
              }
            }
            ls = sx32(ls);
            const float sc = gt2 * (ls > 0.f ? 1.0f / ls : 0.f);
            float* og_rw = ogg + 2048 + lane; asm volatile("" : "+v"(og_rw));
#pragma unroll
            for (int dh = 0; dh < 2; ++dh)
#pragma unroll
                for (int i = 0; i < 16; ++i) og_rw[(dh * 16 + i) * 64] = sc * o[dh][i];
        }
        {
            f32x16 o[2];
#pragma unroll
            for (int i = 0; i < 16; ++i) { o[0][i] = 0.f; o[1][i] = 0.f; }
            float ls = 0.f;
#pragma unroll 1
            for (int m2 = 0; m2 < nu; ++m2) {
                const int n = npW + m2;
                ATT_STEP(); ISSUE_B(n + PFD);
                const int J = BLK_OF(m2);
                const bool mine = MINE_OF(J), alls = ALLS_OF(J);
                if (mine) {
                  const bool sel = (selm[tok * 8 + (J >> 5)] >> (J & 31)) & 1u;
#pragma unroll 1
                  for (int h2 = 0; h2 < 2; ++h2) {
                    const int kv0 = 64 * J + 32 * h2;
                    if (kv0 <= t0 + 7) {
                        const float basef = (float)(t - kv0 - 8 * hi), tb = fmaf(-slope2, basef, -mref1);
                        float e[16];
                        const VFrag vf = vload(SLOT(n, h2), lane);
                        if (kv0 + 31 <= t0) tile_probs<0>(e, SLOT(n, h2), qf, lane, slope2, (alls || sel) ? tb : -1.0e30f, basef, true);
                        else tile_probs<3>(e, SLOT(n, h2), qf, lane, slope2, tb, basef, sel);
#pragma unroll
                        for (int i = 0; i < 16; ++i) ls += e[i];
                        pv32l(o, vf, e);
                    }
                  }
                }
            }
            ls = sx32(ls);
            const float sc = gt1 * (ls > 0.f ? 1.0f / ls : 0.f);
            float* og_rw = ogg + 4096 + lane; asm volatile("" : "+v"(og_rw));
#pragma unroll
            for (int dh = 0; dh < 2; ++dh)
#pragma unroll
                for (int i = 0; i < 16; ++i) og_rw[(dh * 16 + i) * 64] = sc * o[dh][i];
        }
#undef SLOT
#undef BLK_OF
#undef MINE_OF
#undef ALLS_OF
        ATT_DRAIN();
#undef ISSUE_A
#undef ISSUE_B
    }
    {
        int lt = lane; asm volatile("" : "+v"(lt));
        const int hi_t = lt >> 5, hh_t = lt & 3; const size_t row_t = (size_t)b * T_ + t0 + ((lt & 31) >> 2);
        f32x16 o0[2], og[2];
        const float* og_ld = ogp + lt;
#pragma unroll
        for (int dh = 0; dh < 2; ++dh)
#pragma unroll
            for (int i = 0; i < 16; ++i) { const int ix = (dh * 16 + i) * 64; o0[dh][i] = (og_ld[ix] + og_ld[2048 + ix]) + og_ld[4096 + ix]; og[dh][i] = (og_ld[6144 + ix] + og_ld[8192 + ix]) + og_ld[10240 + ix]; }
        float ss = 0.f;
#pragma unroll
        for (int dh = 0; dh < 2; ++dh)
#pragma unroll
            for (int i = 0; i < 16; ++i) ss += o0[dh][i] * o0[dh][i] + og[dh][i] * og[dh][i];
        ss = sx1(ss); ss = sx2(ss); ss = sx32(ss);
        const float rs = rsqrtf(ss * (1.0f / 512.0f) + EPS_);
#pragma unroll
        for (int dh = 0; dh < 2; ++dh)
#pragma unroll
            for (int i4 = 0; i4 < 4; ++i4) {
                u32x2 w; w.x = pk2(o0[dh][4 * i4] * rs, o0[dh][4 * i4 + 1] * rs); w.y = pk2(o0[dh][4 * i4 + 2] * rs, o0[dh][4 * i4 + 3] * rs);
                *(u32x2*)(MIXED + row_t * DM + hh_t * 64 + 32 * dh + 8 * i4 + 4 * hi_t) = w;
                u32x2 w1; w1.x = pk2(og[dh][4 * i4] * rs, og[dh][4 * i4 + 1] * rs); w1.y = pk2(og[dh][4 * i4 + 2] * rs, og[dh][4 * i4 + 3] * rs);
                *(u32x2*)(MIXED + row_t * DM + (4 + hh_t) * 64 + 32 * dh + 8 * i4 + 4 * hi_t) = w1;
            }
    }
    {
        const bf16_t* U = (const bf16_t*)(ws + WS_U); const bf16_t* BG = (const bf16_t*)(ws + WS_BG);
        int lc = lane; asm volatile("" : "+v"(lc));
        const float* cw = p.convw + l * 3 * 512 + 8 * lc;
        float w0[8], w1[8], w2[8];
#pragma unroll
        for (int j = 0; j < 8; ++j) { w0[j] = cw[j]; w1[j] = cw[512 + j]; w2[j] = cw[1024 + j]; }
        asm volatile("" ::: "memory");
        const u32x4 z4 = {0u, 0u, 0u, 0u};
#pragma unroll 1
        for (int half = 0; half < 2; ++half) {
            const int tb0 = t0 + 4 * half; const size_t r0 = (size_t)b * T_ + tb0;
            u32x4 uu[6], bgv[4];
            uu[0] = tb0 >= 2 ? *(const u32x4*)(U + (r0 - 2) * 512 + 8 * lc) : z4;
            uu[1] = tb0 >= 1 ? *(const u32x4*)(U + (r0 - 1) * 512 + 8 * lc) : z4;
#pragma unroll
            for (int tk = 0; tk < 4; ++tk) { uu[2 + tk] = *(const u32x4*)(U + (r0 + tk) * 512 + 8 * lc); bgv[tk] = *(const u32x4*)(BG + (r0 + tk) * 512 + 8 * lc); }
#pragma unroll
            for (int tk = 0; tk < 4; ++tk) {
                const size_t r = r0 + tk;
                const u32x4 u0 = uu[2 + tk], u1 = uu[1 + tk], u2 = uu[tk];
                float v[8]; float ss = 0.f;
#pragma unroll
                for (int j = 0; j < 4; ++j) {
                    v[2 * j] = bflo(bgv[tk][j]) * (w0[2 * j] * bflo(u2[j]) + w1[2 * j] * bflo(u1[j]) + w2[2 * j] * bflo(u0[j]));
                    v[2 * j + 1] = bfhi(bgv[tk][j]) * (w0[2 * j + 1] * bfhi(u2[j]) + w1[2 * j + 1] * bfhi(u1[j]) + w2[2 * j + 1] * bfhi(u0[j]));
                    ss += v[2 * j] * v[2 * j] + v[2 * j + 1] * v[2 * j + 1];
                }
                ss = wave_sum(ss);
                const float rs = rsqrtf(ss * (1.0f / 512.0f) + EPS_);
                u32x4 w; w.x = pk2(v[0] * rs, v[1] * rs); w.y = pk2(v[2] * rs, v[3] * rs); w.z = pk2(v[4] * rs, v[5] * rs); w.w = pk2(v[6] * rs, v[7] * rs);
                *(u32x4*)(MIXED + r * DM + 512 + 8 * lc) = w;
            }
        }
    }
}

#define RLX_AGENT __ATOMIC_RELAXED, __HIP_MEMORY_SCOPE_AGENT
#define XB_TMO      128
#define XB_XCNT(j)  (256  + 64 * (j))
#define XB_XSUB(j)  (1280 + 64 * (j))
#define XB_XGEN(j)  (2304 + 64 * (j))
#define XB_TOP      3328
#define XB_TOPGEN   3392
#define XCD_BAR_WORDS 3456
#define XB_SPIN_CAP (1u << 18)

__device__ __forceinline__ unsigned xb_ld(unsigned* p)              { return __hip_atomic_load(p, __ATOMIC_RELAXED, __HIP_MEMORY_SCOPE_AGENT); }
__device__ __forceinline__ unsigned xb_add(unsigned* p, unsigned v) { return __hip_atomic_fetch_add(p, v, __ATOMIC_RELAXED, __HIP_MEMORY_SCOPE_AGENT); }
__device__ __forceinline__ unsigned xb_xcc_id() { return (unsigned)__builtin_amdgcn_s_getreg((3 << 11) | 20) & 0xFu; }
#define XB_SPIN(cond, bar) do { unsigned _sp = 0; while (cond) { __builtin_amdgcn_s_sleep(1); \
    if ((++_sp & 255u) == 0u) { if (xb_ld(&(bar)[XB_TMO])) break; if (_sp > XB_SPIN_CAP) { atomicAdd(&(bar)[XB_TMO], 1u); break; } } } } while (0)

struct XcdBarrier {
    unsigned* bar; unsigned x; int wv;
    volatile LAS unsigned* st;
};

__device__ __forceinline__ XcdBarrier xcd_barrier_post(unsigned* bar, volatile LAS unsigned* st) {
    XcdBarrier b; b.bar = bar; b.x = xb_xcc_id(); b.st = st;
    if (threadIdx.x == 0) (void)xb_add(&bar[XB_XCNT(b.x)], 1u);
    return b;
}
__device__ __forceinline__ void xcd_barrier_complete(unsigned* bar, unsigned x, unsigned& nloc, unsigned& nx) {
    const unsigned G = gridDim.x * gridDim.y * gridDim.z;
    unsigned sum, cnt, mine, sp = 0u;
    for (;;) {
        sum = 0u; cnt = 0u; mine = 0u;
#pragma unroll
        for (unsigned j = 0; j < 16; ++j) { const unsigned c = xb_ld(&bar[XB_XCNT(j)]); sum += c; cnt += (c > 0u) ? 1u : 0u; mine = (j == x) ? c : mine; }
        if (sum == G) break;
        __builtin_amdgcn_s_sleep(1);
        if ((++sp & 255u) == 0u) { if (xb_ld(&bar[XB_TMO])) break; if (sp > XB_SPIN_CAP) { atomicAdd(&bar[XB_TMO], 1u); break; } }
    }
    nloc = mine > 0u ? mine : 1u; nx = cnt > 0u ? cnt : 1u;
}

__device__ __forceinline__ void xcd_barrier(const XcdBarrier& b) {
    asm volatile("s_waitcnt vmcnt(0)" ::: "memory");
    __syncthreads();
    if (b.wv == 0 && lane_mb() == 0) {
        unsigned* bar = b.bar; unsigned bx_ = b.x; asm volatile("" : "+s"(bar), "+s"(bx_));
        __builtin_amdgcn_s_waitcnt(0);
        unsigned nloc = b.st[0], nx = b.st[1];
        if (nloc == 0u) { xcd_barrier_complete(bar, bx_, nloc, nx); b.st[0] = nloc; b.st[1] = nx; }
        const unsigned old = xb_add(&bar[XB_XSUB(bx_)], 1u);
        const unsigned gen = old / nloc;
        if (old + 1u == (gen + 1u) * nloc) {
            __builtin_amdgcn_fence(__ATOMIC_RELEASE, "agent");
            asm volatile("s_waitcnt vmcnt(0)" ::: "memory");
            const unsigned og = xb_add(&bar[XB_TOP], 1u);
            const unsigned tg = og / nx;
            if (og + 1u == (tg + 1u) * nx) xb_add(&bar[XB_TOPGEN], 1u);
            else XB_SPIN(xb_ld(&bar[XB_TOPGEN]) == tg, bar);
            __builtin_amdgcn_fence(__ATOMIC_ACQUIRE, "agent");
            xb_add(&bar[XB_XGEN(bx_)], 1u);
            asm volatile("s_waitcnt vmcnt(0)" ::: "memory");
        } else {
            XB_SPIN(xb_ld(&bar[XB_XGEN(bx_)]) == gen, bar);
            __builtin_amdgcn_fence(__ATOMIC_ACQUIRE, "agent");
            asm volatile("s_waitcnt vmcnt(0)" ::: "memory");
        }
    }
    __syncthreads();
}

__global__ void __launch_bounds__(512, 2) nsa_trunk_fwd(Params p) {
    extern __shared__ __attribute__((aligned(16))) unsigned char lds[];
    cg::grid_group grid = cg::this_grid();
    LAS unsigned char* L = (LAS unsigned char*)lds;
    const int wave = __builtin_amdgcn_readfirstlane((int)(threadIdx.x >> 6));
#define TID_NOW() (wave * 64 + lane_mb())
#define LANE_NOW() (lane_mb())
    const int G = gridDim.x, gw = blockIdx.x * 8 + wave, ngw = G * 8;
    unsigned char* ws = p.ws;

    if (TID_NOW() == 0) { ((volatile LAS unsigned*)(L + AL_BARST))[0] = 0u; ((volatile LAS unsigned*)(L + AL_BARST))[1] = 0u; }
    __syncthreads();
    XcdBarrier bar = xcd_barrier_post((unsigned*)(ws + WS_BAR), (volatile LAS unsigned*)(L + AL_BARST)); bar.wv = wave;
    { int l0 = LANE_NOW(); asm volatile("" : "+v"(l0)); p0_prep(p, L, gw, ngw, wave, l0); }
    if (p.ws == nullptr) grid.sync();
    xcd_barrier(bar);
#pragma unroll 1
    for (int l = 0; l < DEPTH_; ++l) {
        if (l == 0) {
            const float* part = (const float*)(ws + WS_B1PART); float* b1p = (float*)(ws + WS_B1P);
            int tq = TID_NOW(); asm volatile("" : "+v"(tq));
            if (tq < 8) for (int o = blockIdx.x * 8 + tq; o < 8 * 256; o += G * 8) { const int lk = o >> 8, n = o & 255; float a = 0.f; for (int kc = 0; kc < 32; ++kc) a += part[(size_t)(lk * 32 + kc) * 256 + n]; b1p[o] = a; }
        }
        {
            pg8::Gemm g{(const bf16_t*)(ws + WS_XB), (const bf16_t*)(ws + WS_WIN) + (size_t)l * NIN * DM, M_, NIN, DM};
            pg8::StaticOrder S; S.init(M_, NIN, G, (int)blockIdx.x);
            EpiIn E{ws, p.g_q + l * 64, p.g_k + l * 192, 0.125f * LOG2E_};
            pg8::gemm_phase<EpiIn, pg8::StaticOrder, true, true>(L, g, S, E, wave);
        }
        xcd_barrier(bar);
        { int ln = LANE_NOW(); asm volatile("" : "+v"(ln));
#pragma unroll 1
          for (int u = blockIdx.x; u < 256; u += G) compress_wg_unit(p, l, u, L, wave, ln); }
        xcd_barrier(bar);
        {
            int ln = LANE_NOW(); asm volatile("" : "+v"(ln));
#pragma unroll 1
            for (int u = blockIdx.x; u < 512; u += G) { const int bb = u >= 256 ? 1 : 0, v_ = u & 255, t0_ = (G == 256) ? (v_ & 7) * 32 + (v_ >> 3) : v_, TT = bb ? 255 - t0_ : t0_;     int l2 = ln; asm volatile("" : "+v"(l2)); attn_wg_unit(p, l, bb, TT, L, wave, l2, gw); }
        }
        xcd_barrier(bar);
        {
            pg8::Gemm g{(const bf16_t*)(ws + WS_MIXED), (const bf16_t*)(ws + WS_WO) + (size_t)l * DM * DM, M_, DM, DM};
            pg8::StaticOrder S; S.init(M_, DM, G, (int)blockIdx.x);
            EpiRes E{l == 0 ? p.x : (const float*)p.out, p.out, (bf16_t*)(ws + WS_XB), (float*)(ws + WS_SSPB)};
            pg8::gemm_phase<EpiRes, pg8::StaticOrder, true, true>(L, g, S, E, wave);
        }
        xcd_barrier(bar);
#define FFN_UP(hf_) do { const size_t r0_ = (size_t)(hf_) * (M_ / 2); \
            pg8::Gemm g{(const bf16_t*)(ws + WS_XB) + r0_ * DM, (const bf16_t*)(ws + WS_WUP) + (size_t)l * DFF * DM, M_ / 2, DFF, DM}; \
            pg8::StaticOrder S; S.init(M_ / 2, DFF, G, (int)blockIdx.x); \
            EpiUp E{(const float*)(ws + WS_SSPB) + r0_ * 16, (bf16_t*)(ws + WS_H) + (size_t)(hf_) * (M_ / 2) * DFF}; \
            pg8::gemm_phase<EpiUp, pg8::StaticOrder, true, true>(L, g, S, E, wave); } while (0)
#define FFN_DOWN(hf_) do { const size_t r0_ = (size_t)(hf_) * (M_ / 2); \
            pg8::Gemm g{(const bf16_t*)(ws + WS_H) + (size_t)(hf_) * (M_ / 2) * DFF, (const bf16_t*)(ws + WS_WDN) + (size_t)l * DM * DFF, M_ / 2, DM, DFF}; \
            pg8::StaticOrder S; S.init(M_ / 2, DM, G, (int)blockIdx.x); \
            EpiRes E{(const float*)p.out + r0_ * DM, p.out + r0_ * DM, (l + 1 < DEPTH_) ? (bf16_t*)(ws + WS_XB) + r0_ * DM : (bf16_t*)nullptr, (float*)(ws + WS_SSPA) + r0_ * 16}; \
            pg8::gemm_phase<EpiRes, pg8::StaticOrder, true, true>(L, g, S, E, wave); } while (0)
        FFN_UP(0);
        xcd_barrier(bar);
        FFN_DOWN(0);
        __syncthreads();
        FFN_UP(1);
        xcd_barrier(bar);
        FFN_DOWN(1);
#undef FFN_UP
#undef FFN_DOWN
        if (l + 1 < DEPTH_) xcd_barrier(bar);
    }
}

extern "C" void kernel_launch(void* const* d_in, const int* in_sizes, int n_in, void* d_out, int out_size, void* d_ws, size_t ws_size, hipStream_t stream) {
    static int grid = 0;
    if (grid == 0) {
        if (n_in != 16 || ws_size < WS_END) { fprintf(stderr, "kernel_launch: unexpected inputs (n_in %d, ws %zu)\n", n_in, ws_size); grid = -1; return; }
        int dev = 0, cus = 0, per_cu = 0;
        hipGetDevice(&dev); hipDeviceGetAttribute(&cus, hipDeviceAttributeMultiprocessorCount, dev);
        hipFuncSetAttribute((const void*)nsa_trunk_fwd, hipFuncAttributeMaxDynamicSharedMemorySize, LDS_BYTES);
        hipOccupancyMaxActiveBlocksPerMultiprocessor(&per_cu, (const void*)nsa_trunk_fwd, 512, LDS_BYTES);
        if (per_cu < 1) per_cu = 1;
        grid = cus * per_cu;
        (void)hipGetLastError();
    }
    if (grid < 0) return;
    Params p{};
    p.x = (const float*)d_in[0]; p.g_mix = (const float*)d_in[1]; p.w_in = (const float*)d_in[2]; p.g_q = (const float*)d_in[3]; p.g_k = (const float*)d_in[4];
    p.pe = (const float*)d_in[5]; p.w1 = (const float*)d_in[6]; p.b1 = (const float*)d_in[7]; p.w2 = (const float*)d_in[8]; p.b2 = (const float*)d_in[9];
    p.convw = (const float*)d_in[10]; p.g_out = (const float*)d_in[11]; p.w_o = (const float*)d_in[12]; p.g_ffn = (const float*)d_in[13]; p.w_up = (const float*)d_in[14]; p.w_dn = (const float*)d_in[15];
    p.out = (float*)d_out; p.ws = (unsigned char*)d_ws;
    if (hipMemsetAsync((unsigned char*)d_ws + WS_BAR, 0, 16384, stream) != hipSuccess) { fprintf(stderr, "kernel_launch: memset of the barrier words failed\n"); return; }
    void* args[] = {&p};
    hipError_t e = hipLaunchCooperativeKernel((const void*)nsa_trunk_fwd, dim3(grid), dim3(512), args, LDS_BYTES, stream);
    if (e != hipSuccess) fprintf(stderr, "cooperative launch failed: %s (grid %d)\n", hipGetErrorString(e), grid);
}
```
